# Optimizing an MI355X kernel written in HIP

```python
import jax, jax.numpy as jnp
from jax import lax
import numpy as np

D_MODEL = 1024
BATCH = 32
SEQ = 2048
DEPTH = 1

CHUNK = 128
A_GROUPS = 8
A_GROUP_DIM = D_MODEL // A_GROUPS
A_WIDTH = A_GROUPS * A_GROUP_DIM
B_HEADS = 8
B_HEAD_DIM = D_MODEL // B_HEADS
B_WIDTH = B_HEADS * B_HEAD_DIM
Q_BLOCK = 128
EPS = 1e-6

IN_WIDTHS = (A_WIDTH, A_WIDTH, A_WIDTH, B_WIDTH, B_WIDTH, B_WIDTH, B_WIDTH, D_MODEL, D_MODEL)
IN_PROJ_WIDTH = sum(IN_WIDTHS)
SPLIT_POINTS = tuple(int(p) for p in np.cumsum(IN_WIDTHS)[:-1])

kernel_name = "hybrid_gmlp_stickbreaking_gated_block"


def rms_norm(x, gain):
    xf = x.astype(jnp.float32)
    y = xf * lax.rsqrt(jnp.mean(xf * xf, axis=-1, keepdims=True) + EPS)
    return (y * gain.astype(jnp.float32)).astype(x.dtype)


def chunked_spatial_gating(u, v, w_s, b_s):
    bsz, seq, _ = u.shape
    n_chunks = seq // CHUNK
    vr = v.reshape(bsz, n_chunks, CHUNK, A_GROUPS, A_GROUP_DIM)
    causal = jnp.tril(jnp.ones((CHUNK, CHUNK), dtype=bool))
    w = jnp.where(causal[None], w_s, 0.0).astype(v.dtype)
    mixed = jnp.einsum('gts,bnsgc->bntgc', w, vr)
    mixed = mixed + b_s.T.astype(v.dtype)[None, None, :, :, None]
    return u * mixed.reshape(bsz, seq, A_WIDTH)


def stick_breaking_attention(q, k, v):
    bsz, seq, n_heads, head_dim = q.shape
    n_blocks = seq // Q_BLOCK
    scale = head_dim ** -0.5
    q_blocks = q.reshape(bsz, n_blocks, Q_BLOCK, n_heads, head_dim).transpose(1, 0, 2, 3, 4)
    key_pos = jnp.arange(seq)

    def one_block(args):
        q_blk, blk_idx = args
        logits = jnp.einsum('bthd,bshd->bhts', q_blk, k).astype(jnp.float32) * scale
        q_pos = blk_idx * Q_BLOCK + jnp.arange(Q_BLOCK)
        causal = key_pos[None, :] < q_pos[:, None]
        log_beta = jax.nn.log_sigmoid(logits)
        log_one_minus = jnp.where(causal, log_beta - logits, 0.0)
        suffix = lax.cumsum(log_one_minus, axis=3, reverse=True) - log_one_minus
        weights = jnp.where(causal, jnp.exp(log_beta + suffix), 0.0)
        return jnp.einsum('bhts,bshd->bthd', weights.astype(v.dtype), v)

    out = lax.map(one_block, (q_blocks, jnp.arange(n_blocks)))
    return out.transpose(1, 0, 2, 3, 4).reshape(bsz, seq, n_heads, head_dim)


def setup_inputs(seed: int = 0) -> dict:
    key = jax.random.key(seed)
    ks = jax.random.split(key, 11)
    f32 = jnp.float32
    x = jax.random.normal(ks[0], (BATCH, SEQ, D_MODEL), f32)
    norm_in = 1.0 + 0.02 * jax.random.normal(ks[1], (DEPTH, D_MODEL), f32)
    w_in = jax.random.normal(ks[2], (DEPTH, D_MODEL, IN_PROJ_WIDTH), f32) * D_MODEL ** -0.5
    norm_v = 1.0 + 0.02 * jax.random.normal(ks[3], (DEPTH, A_WIDTH), f32)
    w_s = jax.random.normal(ks[4], (DEPTH, A_GROUPS, CHUNK, CHUNK), f32) * (0.5 * CHUNK ** -0.5)
    b_s = 1.0 + 0.02 * jax.random.normal(ks[5], (DEPTH, A_GROUPS, CHUNK), f32)
    w_o_gmlp = jax.random.normal(ks[6], (DEPTH, A_WIDTH, D_MODEL), f32) * A_WIDTH ** -0.5
    w_o_sb = jax.random.normal(ks[7], (DEPTH, B_WIDTH, D_MODEL), f32) * B_WIDTH ** -0.5
    w_out = jax.random.normal(ks[8], (DEPTH, D_MODEL, D_MODEL), f32) * D_MODEL ** -0.5
    norm_final = 1.0 + 0.02 * jax.random.normal(ks[9], (D_MODEL,), f32)
    return {"x": x, "norm_in": norm_in, "w_in": w_in, "norm_v": norm_v, "w_s": w_s,
            "b_s": b_s, "w_o_gmlp": w_o_gmlp, "w_o_sb": w_o_sb, "w_out": w_out,
            "norm_final": norm_final}


def reference(x, norm_in, w_in, norm_v, w_s, b_s, w_o_gmlp, w_o_sb, w_out, norm_final):
    bsz, seq, _ = x.shape
    for layer in range(DEPTH):
        h = rms_norm(x, norm_in[layer])
        proj = jnp.einsum('bsd,de->bse', h, w_in[layer])
        u_a, v_a, z_a, q_b, k_b, v_b, z_b, gate_a, gate_b = jnp.split(proj, SPLIT_POINTS, axis=-1)

        u_a = jax.nn.gelu(u_a)
        v_a = rms_norm(jax.nn.gelu(v_a), norm_v[layer])
        y_a = chunked_spatial_gating(u_a, v_a, w_s[layer], b_s[layer]) * jax.nn.silu(z_a)

        heads = lambda t: t.reshape(bsz, seq, B_HEADS, B_HEAD_DIM)
        y_b = stick_breaking_attention(heads(q_b), heads(k_b), heads(v_b)).reshape(bsz, seq, B_WIDTH)
        y_b = y_b * jax.nn.silu(z_b)

        p_a = jnp.einsum('bse,ed->bsd', y_a, w_o_gmlp[layer])
        p_b = jnp.einsum('bse,ed->bsd', y_b, w_o_sb[layer])
        merged = jax.nn.sigmoid(gate_a) * p_a + jax.nn.sigmoid(gate_b) * p_b
        x = x + jnp.einsum('bsd,de->bse', merged, w_out[layer])
    return rms_norm(x, norm_final)
```

```cpp
#include <hip/hip_runtime.h>
#include <hip/hip_cooperative_groups.h>
#include <cstdio>
#include <cstdint>
namespace cg = cooperative_groups;

#define LAS __attribute__((address_space(3)))
#define GAS __attribute__((address_space(1)))
typedef unsigned short bf16_t;
typedef short bf16x8 __attribute__((ext_vector_type(8)));
typedef short s16x4 __attribute__((ext_vector_type(4)));
typedef float f32x4 __attribute__((ext_vector_type(4)));
typedef float f32x2 __attribute__((ext_vector_type(2)));
typedef float f32x16 __attribute__((ext_vector_type(16)));
typedef unsigned u32x4 __attribute__((ext_vector_type(4)));
typedef unsigned u32x2 __attribute__((ext_vector_type(2)));
typedef __bf16 bf16x2_t __attribute__((ext_vector_type(2)));

constexpr int DM = 1024, BATCH = 32, SEQ = 2048, M = BATCH * SEQ;
constexpr int NIN = 9216, NH = 8, HD = 128, CHUNK = 128, NG = 8;
constexpr float EPS = 1e-6f;
constexpr float LOG2E = 1.4426950408889634f;

constexpr size_t MiB = 1u << 20;
constexpr size_t WS_CTL = 0, CTL_BYTES = 131072;
constexpr size_t WS_WIN = 2 * MiB, WS_WCAT = 20 * MiB, WS_WOUT = 24 * MiB, WS_SSV = 26 * MiB, WS_SSF = 30 * MiB;
constexpr size_t WS_YAB = 64 * MiB, WS_VA = 320 * MiB, WS_VB = 448 * MiB, WS_ZB = 576 * MiB, WS_GA = 704 * MiB, WS_GB = 832 * MiB, WS_END = 960 * MiB;
constexpr int LDS_RING = 131072, LDS_MISC = 131072, LDS_BYTES = 147456;

__device__ __forceinline__ float ex2(float x) { return __builtin_amdgcn_exp2f(x); }
__device__ __forceinline__ float rcpf_(float x) { return __builtin_amdgcn_rcpf(x); }
__device__ __forceinline__ unsigned pk_bf16(float lo, float hi) { f32x2 v = {lo, hi}; bf16x2_t b = __builtin_convertvector(v, bf16x2_t); return __builtin_bit_cast(unsigned, b); }
__device__ __forceinline__ float bf_lo(unsigned w) { return __uint_as_float(w << 16); }
__device__ __forceinline__ float bf_hi(unsigned w) { return __uint_as_float(w & 0xffff0000u); }
__device__ __forceinline__ float sigmoidf_(float x) { return rcpf_(1.f + ex2(-x * LOG2E)); }
constexpr float GC0 = -1.5957691216057308f * LOG2E, GC1 = -1.5957691216057308f * 0.044715f * LOG2E;
__device__ __forceinline__ float gelu_e(float x) { return ex2(x * (GC0 + GC1 * (x * x))); }
__device__ __forceinline__ float gelu_tanh(float x) { return x * rcpf_(1.f + gelu_e(x)); }
__device__ __forceinline__ float siluf_(float x) { return x * sigmoidf_(x); }
__device__ __forceinline__ float xsum_fq(float v) {
    const auto a = __builtin_amdgcn_permlane16_swap(__float_as_uint(v), __float_as_uint(v), false, false);
    const float t = __uint_as_float(a[0]) + __uint_as_float(a[1]);
    const auto b = __builtin_amdgcn_permlane32_swap(__float_as_uint(t), __float_as_uint(t), false, false);
    return __uint_as_float(b[0]) + __uint_as_float(b[1]);
}
__device__ __forceinline__ float wave_sum(float v) {
#pragma unroll
    for (int o = 1; o < 64; o <<= 1) v += __shfl_xor(v, o);
    return v;
}

#ifndef KDUP
#define KDUP 1
#endif
namespace pg8 {
constexpr int BM = 256, BK = 64, HALF = 128, HTB = HALF * BK * 2, STAGE_BYTES = 8 * HTB, NXCD = 8, WGM = 8;
__host__ __device__ __forceinline__ int lds_byte(int r, int c) { const int st = (r >> 4) * 2 + (c >> 5), rr = r & 15, cc = c & 31, ob = rr * 64 + cc * 2; return st * 1024 + (ob ^ (((ob >> 9) & 1) << 5)); }
__host__ __device__ __forceinline__ void stage_rc(int b, int& R, int& C) { const int st = b / 1024, sb = b % 1024, swz = sb ^ (((sb >> 9) & 1) << 5); R = (st >> 1) * 16 + swz / 64; C = (st & 1) * 32 + (swz % 64) / 2; }
__host__ __device__ __forceinline__ int perm32(int rho) { const int n = rho >> 4, i = rho & 15; return 8 * (i >> 2) + 4 * n + (i & 3); }
struct Unit { int pm, pn; };
struct Gemm { const bf16_t* A; const bf16_t* Bt; int M, N, K; };
struct StaticOrder {
    int nM, nN, nwg, G, c, rep, dup;
    __device__ void init(int M_, int N_, int G_, int c_, int rep_ = 1, int dup_ = 1) { nM = M_ / BM; nN = N_ / BM; nwg = nM * nN; G = G_; c = c_; rep = rep_; dup = dup_; }
    __device__ bool next(int i, Unit& u) const {
        long L = (long)(i / dup) * G + c; if (L >= (long)nwg * rep) return false; L %= nwg;
        int wgid = (int)L; { const int q = nwg / NXCD, r = nwg % NXCD, xcd = wgid % NXCD, off = wgid / NXCD; wgid = (xcd < r ? xcd * (q + 1) : r * (q + 1) + (xcd - r) * q) + off; }
        const int nig = WGM * nN, gid = wgid / nig, fm = gid * WGM, gsz = (nM - fm) < WGM ? (nM - fm) : WGM;
        u.pm = fm + ((wgid % nig) % gsz); u.pn = (wgid % nig) / gsz; return true;
    }
};
struct PanelOrder {
    int nM, nN, G, c, rep;
    __device__ void init(int M_, int N_, int G_, int c_, int rep_ = 1) { nM = M_ / BM; nN = N_ / BM; G = G_; c = c_; rep = rep_; }
    __device__ bool next(int i, Unit& u) const { const int pm = c + G * (i / (nN * rep)); if (pm >= nM) return false; u.pm = pm; u.pn = i % nN; return true; }
};

template <class Epi, class Sched>
__device__ __forceinline__ void gemm_phase(LAS unsigned char* lds, const Gemm g, const Sched& S, const Epi& E) {
    const int tid = threadIdx.x, wid = __builtin_amdgcn_readfirstlane(tid >> 6), lane = tid & 63, wr = wid >> 2, wc = wid & 3, fr = lane & 15, fq = lane >> 4;
    const int K = g.K, nt = K / BK;
    unsigned voffA[2], voffB[2];
#pragma unroll
    for (int i = 0; i < 2; ++i) { int R, C; stage_rc(tid * 16 + i * 8192, R, C); const int Rb = Epi::PERM ? ((R & ~31) + perm32(R & 31)) : R;
        voffA[i] = (unsigned)(R * K + C) * 2u; voffB[i] = (unsigned)(Rb * K + C) * 2u; }
    const size_t kstep = (size_t)(BK * 2);
    const size_t hstep = (size_t)HALF * K * 2;
    const size_t tstep = 2 * hstep;
    const unsigned ldsw = (unsigned)wid * 1024u;
    const int aoff = lds_byte(wr * 64 + fr, fq * 8), boff = lds_byte(wc * 32 + fr, fq * 8);
#define PG8_SA(b, h) (((b) * 2 + (h)) * HTB)
#define PG8_SB(b, h) ((4 + (b) * 2 + (h)) * HTB)
#define PG8_STAGE(bufoff, gbase, voff) do { _Pragma("unroll") for (int _i = 0; _i < 2; ++_i) \
        __builtin_amdgcn_global_load_lds((const unsigned*)((const char*)(gbase) + (voff)[_i]), (LAS unsigned*)(lds + (bufoff) + ldsw + _i * 8192), 16, 0, 0); } while (0)
#define PG8_LDA(dst, b, h) do { _Pragma("unroll") for (int m = 0; m < 4; ++m) _Pragma("unroll") for (int k = 0; k < 2; ++k) dst[m][k] = *(const LAS bf16x8*)(lds + PG8_SA(b, h) + aoff + m * 2048 + k * 1024); } while (0)
#define PG8_LDB(dst, b, h) do { _Pragma("unroll") for (int n = 0; n < 2; ++n) _Pragma("unroll") for (int k = 0; k < 2; ++k) dst[n][k] = *(const LAS bf16x8*)(lds + PG8_SB(b, h) + boff + n * 2048 + k * 1024); } while (0)
#define PG8_MMA(ai, bj, At, Bt) do { __builtin_amdgcn_s_setprio(1); _Pragma("unroll") for (int m = 0; m < 4; ++m) _Pragma("unroll") for (int n = 0; n < 2; ++n) _Pragma("unroll") for (int k = 0; k < 2; ++k) \
        acc[ai][bj][m][n] = __builtin_amdgcn_mfma_f32_16x16x32_bf16(Bt[n][k], At[m][k], acc[ai][bj][m][n], 0, 0, 0); __builtin_amdgcn_s_setprio(0); } while (0)
#define PG8_WAIT_V(n) asm volatile("s_waitcnt vmcnt(" #n ")" ::: "memory")
#define PG8_WAIT_L(n) asm volatile("s_waitcnt lgkmcnt(" #n ")" ::: "memory")
#define PG8_BAR __builtin_amdgcn_s_barrier()
#define PG8_SCHED __builtin_amdgcn_sched_barrier(0)
#define PG8_KBODY(t) do { \
            const bool last = (t == nt - 2); \
            const char* a1 = cA + (size_t)(t + 1) * kstep; \
            const char* a2 = last ? nA : cA + (size_t)(t + 2) * kstep; const char* b2 = last ? nB : cB + (size_t)(t + 2) * kstep; \
            const char* a3 = a2 + kstep; const char* b3 = b2 + kstep; \
            PG8_LDB(B0, 0, 0); PG8_LDB(B1, 0, 1); PG8_SCHED; PG8_LDA(At, 0, 0); PG8_STAGE(PG8_SA(1, 1), a1 + hstep, voffA); \
            PG8_WAIT_V(8); PG8_WAIT_L(0); PG8_BAR; PG8_MMA(0, 0, At, B0); PG8_MMA(0, 1, At, B1); PG8_BAR; PG8_SCHED; \
            PG8_LDA(At, 0, 1); PG8_STAGE(PG8_SB(0, 0), b2, voffB); PG8_STAGE(PG8_SB(0, 1), b2 + hstep, voffB); PG8_STAGE(PG8_SA(0, 0), a2, voffA); \
            PG8_WAIT_V(8); PG8_WAIT_L(0); PG8_BAR; PG8_MMA(1, 0, At, B0); PG8_MMA(1, 1, At, B1); PG8_BAR; PG8_SCHED; \
            PG8_LDB(B0, 1, 0); PG8_LDB(B1, 1, 1); PG8_SCHED; PG8_LDA(At, 1, 0); PG8_STAGE(PG8_SA(0, 1), a2 + hstep, voffA); \
            PG8_WAIT_V(8); PG8_WAIT_L(0); PG8_BAR; PG8_MMA(0, 0, At, B0); PG8_MMA(0, 1, At, B1); PG8_BAR; PG8_SCHED; \
            PG8_LDA(At, 1, 1); PG8_STAGE(PG8_SB(1, 0), b3, voffB); PG8_STAGE(PG8_SB(1, 1), b3 + hstep, voffB); PG8_STAGE(PG8_SA(1, 0), a3, voffA); \
            PG8_WAIT_V(8); PG8_WAIT_L(0); PG8_BAR; PG8_MMA(1, 0, At, B0); PG8_MMA(1, 1, At, B1); PG8_BAR; PG8_SCHED; \
        } while (0)
    Unit cur, nxt; int ui = 0;
    if (!S.next(0, cur)) return;
    f32x4 acc[2][2][4][2];
#pragma unroll
    for (int a = 0; a < 2; ++a)
#pragma unroll
        for (int b = 0; b < 2; ++b)
#pragma unroll
            for (int m = 0; m < 4; ++m)
#pragma unroll
                for (int n = 0; n < 2; ++n) acc[a][b][m][n] = (f32x4){0.f, 0.f, 0.f, 0.f};
    bf16x8 At[4][2], B0[2][2], B1[2][2];
    const char* cA = (const char*)g.A + (size_t)cur.pm * tstep; const char* cB = (const char*)g.Bt + (size_t)cur.pn * tstep;
    PG8_STAGE(PG8_SB(0, 0), cB, voffB); PG8_STAGE(PG8_SB(0, 1), cB + hstep, voffB); PG8_STAGE(PG8_SA(0, 0), cA, voffA); PG8_STAGE(PG8_SA(0, 1), cA + hstep, voffA);
    if (wr == 1) PG8_BAR;
    PG8_WAIT_V(2); PG8_BAR;
    PG8_STAGE(PG8_SB(1, 0), cB + kstep, voffB); PG8_STAGE(PG8_SA(1, 0), cA + kstep, voffA); PG8_STAGE(PG8_SB(1, 1), cB + hstep + kstep, voffB);
    PG8_WAIT_V(6); PG8_BAR;
    for (;;) {
        const bool has_next = S.next(ui + 1, nxt);
        const char* nA = has_next ? (const char*)g.A + (size_t)nxt.pm * tstep : cA; const char* nB = has_next ? (const char*)g.Bt + (size_t)nxt.pn * tstep : cB;
        if constexpr (Epi::MIDHOOK) {
            for (int t = 0; t < nt / 2; t += 2) PG8_KBODY(t);
            E.mid(acc, cur, wr, wc, fr, fq);
            for (int t = nt / 2; t < nt; t += 2) PG8_KBODY(t);
        } else {
            for (int t = 0; t < nt; t += 2) PG8_KBODY(t);
        }
        if (wr == 0) PG8_BAR;
        if constexpr (Epi::FUSED) E.fused(acc, cur, wr, wc, fr, fq, lds + 131072, wid, lane); else { if (KDUP == 1 || !Epi::DUPSKIP || (ui % KDUP) == KDUP - 1) E(acc, cur, wr, wc, fr, fq); }
        if (!has_next) break;
#pragma unroll
        for (int a = 0; a < 2; ++a)
#pragma unroll
            for (int b = 0; b < 2; ++b)
#pragma unroll
                for (int m = 0; m < 4; ++m)
#pragma unroll
                    for (int n = 0; n < 2; ++n) acc[a][b][m][n] = (f32x4){0.f, 0.f, 0.f, 0.f};
        cur = nxt; cA = nA; cB = nB; ++ui;
        if (wr == 1) PG8_BAR;
    }
    PG8_WAIT_V(0);
    PG8_BAR;
#undef PG8_KBODY
#undef PG8_SA
#undef PG8_SB
#undef PG8_STAGE
#undef PG8_LDA
#undef PG8_LDB
#undef PG8_MMA
#undef PG8_WAIT_V
#undef PG8_WAIT_L
#undef PG8_BAR
#undef PG8_SCHED
}
}

__device__ __forceinline__ void st_out(u32x4* p, u32x4 w, bool keep) { if (keep) *p = w; else __builtin_nontemporal_store(w, p); }
struct EpiP1 {
    static constexpr bool PERM = true, MIDHOOK = false, FUSED = false, DUPSKIP = true;
    bf16_t *YAB, *VA, *KB, *VB, *ZB, *GA, *GB; float* ssv; LAS float* pss;
    template <int ACT> __device__ __forceinline__ void plain(const f32x4 (&acc)[2][2][4][2], bf16_t* base, int ldc, int row0, int colt, int slot, int fq, bool keep) const {
        const float qs = 0.08838834764831845f * LOG2E;
#pragma unroll
        for (int ai = 0; ai < 2; ++ai)
#pragma unroll
            for (int m = 0; m < 4; ++m) {
                const int row = row0 + ai * 128 + m * 16; float ss = 0.f;
#pragma unroll
                for (int bj = 0; bj < 2; ++bj) {
                    float o[8];
#pragma unroll
                    for (int n = 0; n < 2; ++n)
#pragma unroll
                        for (int j = 0; j < 4; ++j) { float v = acc[ai][bj][m][n][j];
                            if (ACT == 1) { v = gelu_tanh(v); ss += v * v; } else if (ACT == 2) v *= qs; else if (ACT == 3) v = v * rcpf_(1.f + ex2(-v * LOG2E));
                            o[n * 4 + j] = v; }
                    u32x4 w; w.x = pk_bf16(o[0], o[1]); w.y = pk_bf16(o[2], o[3]); w.z = pk_bf16(o[4], o[5]); w.w = pk_bf16(o[6], o[7]);
                    st_out((u32x4*)(base + (size_t)row * ldc + colt + bj * 128), w, keep);
                }
                if (ACT == 1) { ss = xsum_fq(ss); if (fq == 0) pss[((row & 255) << 2) + (slot & 3)] = ss; }
            }
        if (ACT == 1) {
            asm volatile("s_waitcnt lgkmcnt(0)" ::: "memory"); __builtin_amdgcn_s_barrier(); asm volatile("" ::: "memory");
            const int tid = threadIdx.x;
            if (tid < 256) { const f32x4 p = *((const LAS f32x4*)pss + tid); *(f32x4*)(ssv + (size_t)((row0 & ~255) + tid) * 16 + (slot & ~3)) = p; }
        }
    }
    __device__ __forceinline__ void operator()(const f32x4 (&acc)[2][2][4][2], const pg8::Unit& u, int wr, int wc, int fr, int fq) const {
        const int pn = u.pn; const int row0 = u.pm * 256 + wr * 64 + fr; const int cw = wc * 32 + 8 * fq;
        const bool keep = (u.pm & 31) >= 24;
        if (pn < 8) {
            const int col = pn * 128 + cw;
#pragma unroll
            for (int ai = 0; ai < 2; ++ai)
#pragma unroll
                for (int m = 0; m < 4; ++m) {
                    float o[8];
#pragma unroll
                    for (int n = 0; n < 2; ++n)
#pragma unroll
                        for (int j = 0; j < 4; ++j) { const float uu = acc[ai][0][m][n][j], zz = acc[ai][1][m][n][j]; o[n * 4 + j] = (uu * zz) * rcpf_((1.f + gelu_e(uu)) * (1.f + ex2(-zz * LOG2E))); }
                    u32x4 w; w.x = pk_bf16(o[0], o[1]); w.y = pk_bf16(o[2], o[3]); w.z = pk_bf16(o[4], o[5]); w.w = pk_bf16(o[6], o[7]);
                    st_out((u32x4*)(YAB + (size_t)(row0 + ai * 128 + m * 16) * 2048 + col), w, keep);
                }
        } else if (pn < 28) {
            const int seg = (pn - 8) >> 2; const int colt = ((pn - 8) & 3) * 256 + cw;
            if (seg == 0) plain<1>(acc, VA, 1024, row0, colt, (pn - 8) * 4 + wc, fq, keep);
            else if (seg == 1) plain<2>(acc, YAB + 1024, 2048, row0, colt, 0, fq, keep);
            else if (seg == 2) plain<0>(acc, KB, 1024, row0, colt, 0, fq, keep);
            else if (seg == 3) plain<0>(acc, VB, 1024, row0, colt, 0, fq, keep);
            else plain<3>(acc, ZB, 1024, row0, colt, 0, fq, keep);
        } else {
            const int col = (pn - 28) * 128 + cw;
#pragma unroll
            for (int ai = 0; ai < 2; ++ai)
#pragma unroll
                for (int m = 0; m < 4; ++m) {
                    float oa[8], ob[8];
#pragma unroll
                    for (int n = 0; n < 2; ++n)
#pragma unroll
                        for (int j = 0; j < 4; ++j) { const float ea = ex2(fminf(-acc[ai][0][m][n][j] * LOG2E, 60.f)), eb = ex2(fminf(-acc[ai][1][m][n][j] * LOG2E, 60.f));
                            oa[n * 4 + j] = (1.f + eb) * rcpf_(1.f + ea); ob[n * 4 + j] = rcpf_(1.f + eb); }
                    u32x4 w; w.x = pk_bf16(oa[0], oa[1]); w.y = pk_bf16(oa[2], oa[3]); w.z = pk_bf16(oa[4], oa[5]); w.w = pk_bf16(oa[6], oa[7]);
                    u32x4 x; x.x = pk_bf16(ob[0], ob[1]); x.y = pk_bf16(ob[2], ob[3]); x.z = pk_bf16(ob[4], ob[5]); x.w = pk_bf16(ob[6], ob[7]);
                    const size_t off = (size_t)(row0 + ai * 128 + m * 16) * 1024 + col;
                    __builtin_nontemporal_store(w, (u32x4*)(GA + off)); __builtin_nontemporal_store(x, (u32x4*)(GB + off));
                }
        }
    }
};
struct EpiP3 {
    static constexpr bool PERM = true, MIDHOOK = true, FUSED = false, DUPSKIP = false;
    const bf16_t *GA, *GB; bf16_t* MG;
    __device__ __forceinline__ void mid(f32x4 (&acc)[2][2][4][2], const pg8::Unit& u, int wr, int wc, int fr, int fq) const {
        const int row0 = u.pm * 256 + wr * 64 + fr; const int col0 = u.pn * 256 + wc * 32 + 8 * fq;
        unsigned base_off = (unsigned)row0 * 1024u + (unsigned)col0; asm volatile("" : "+v"(base_off));
#pragma unroll
        for (int ai = 0; ai < 2; ++ai) {
            u32x4 a[4][2];
#pragma unroll
            for (int m = 0; m < 4; ++m)
#pragma unroll
                for (int bj = 0; bj < 2; ++bj) a[m][bj] = *(const u32x4*)(GA + base_off + (unsigned)((ai * 128 + m * 16) * 1024 + bj * 128));
#pragma unroll
            for (int m = 0; m < 4; ++m)
#pragma unroll
                for (int bj = 0; bj < 2; ++bj) { const u32x4 r = a[m][bj];
                    acc[ai][bj][m][0] *= (f32x4){bf_lo(r.x), bf_hi(r.x), bf_lo(r.y), bf_hi(r.y)}; acc[ai][bj][m][1] *= (f32x4){bf_lo(r.z), bf_hi(r.z), bf_lo(r.w), bf_hi(r.w)}; }
            asm volatile("" : "+v"(acc[ai][0][0][0]), "+v"(acc[ai][0][0][1]), "+v"(acc[ai][1][0][0]), "+v"(acc[ai][1][0][1]), "+v"(acc[ai][0][1][0]), "+v"(acc[ai][0][1][1]), "+v"(acc[ai][1][1][0]), "+v"(acc[ai][1][1][1]),
                              "+v"(acc[ai][0][2][0]), "+v"(acc[ai][0][2][1]), "+v"(acc[ai][1][2][0]), "+v"(acc[ai][1][2][1]), "+v"(acc[ai][0][3][0]), "+v"(acc[ai][0][3][1]), "+v"(acc[ai][1][3][0]), "+v"(acc[ai][1][3][1]) :: "memory");
        }
    }
    __device__ __forceinline__ void operator()(const f32x4 (&acc)[2][2][4][2], const pg8::Unit& u, int wr, int wc, int fr, int fq) const {
        const int row0 = u.pm * 256 + wr * 64 + fr; const int col0 = u.pn * 256 + wc * 32 + 8 * fq;
        const bf16_t* GB2 = GB; asm volatile("" : "+s"(GB2));
        unsigned base_off = (unsigned)row0 * 1024u + (unsigned)col0; asm volatile("" : "+v"(base_off));
        u32x4 b[2][4][2];
#pragma unroll
        for (int ai = 0; ai < 2; ++ai)
#pragma unroll
            for (int m = 0; m < 4; ++m)
#pragma unroll
                for (int bj = 0; bj < 2; ++bj) b[ai][m][bj] = *(const u32x4*)(GB2 + base_off + (unsigned)((ai * 128 + m * 16) * 1024 + bj * 128));
#pragma unroll
        for (int ai = 0; ai < 2; ++ai)
#pragma unroll
            for (int m = 0; m < 4; ++m)
#pragma unroll
                for (int bj = 0; bj < 2; ++bj) {
                    const unsigned off = base_off + (unsigned)((ai * 128 + m * 16) * 1024 + bj * 128);
                    const u32x4 gb = b[ai][m][bj];
                    const f32x4 v0 = acc[ai][bj][m][0], v1 = acc[ai][bj][m][1];
                    u32x4 w; w.x = pk_bf16(v0[0] * bf_lo(gb.x), v0[1] * bf_hi(gb.x)); w.y = pk_bf16(v0[2] * bf_lo(gb.y), v0[3] * bf_hi(gb.y));
                    w.z = pk_bf16(v1[0] * bf_lo(gb.z), v1[1] * bf_hi(gb.z)); w.w = pk_bf16(v1[2] * bf_lo(gb.w), v1[3] * bf_hi(gb.w));
                    __builtin_nontemporal_store(w, (u32x4*)(MG + off));
                }
        asm volatile("" ::: "memory");
    }
};
struct EpiP4 {
    static constexpr bool PERM = false, MIDHOOK = false, FUSED = true, DUPSKIP = false;
    const float* x; float* out; const float* gain; float* slots; unsigned* cnt;
    __device__ __forceinline__ void fused(f32x4 (&acc)[2][2][4][2], const pg8::Unit& u, int wr, int wc, int fr, int fq, LAS unsigned char* ldsm, int wid, int lane) const {
        LAS float* P = (LAS float*)(ldsm + 1024);
        LAS float* S = (LAS float*)(ldsm + 1024 + 4096);
        const int row0 = u.pm * 256 + wr * 64 + fr; const int col0 = u.pn * 256 + wc * 32 + 4 * fq;
#pragma unroll
        for (int ai = 0; ai < 2; ++ai)
#pragma unroll
            for (int m = 0; m < 4; ++m) {
                const int row = row0 + ai * 128 + m * 16; float ss = 0.f;
#pragma unroll
                for (int bj = 0; bj < 2; ++bj)
#pragma unroll
                    for (int n = 0; n < 2; ++n) {
                        const f32x4 v = *(const f32x4*)(x + (size_t)row * 1024 + col0 + bj * 128 + n * 16) + acc[ai][bj][m][n];
                        ss += (v[0] * v[0] + v[1] * v[1]) + (v[2] * v[2] + v[3] * v[3]);
                        acc[ai][bj][m][n] = v;
                    }
                ss = xsum_fq(ss);
                if (fq == 0) P[(ai * 128 + wr * 64 + m * 16 + fr) * 4 + wc] = ss;
                if (m & 1) asm volatile("" : "+v"(acc[ai][0][m][0]), "+v"(acc[ai][0][m][1]), "+v"(acc[ai][1][m][0]), "+v"(acc[ai][1][m][1]), "+v"(acc[ai][0][m - 1][0]), "+v"(acc[ai][0][m - 1][1]), "+v"(acc[ai][1][m - 1][0]), "+v"(acc[ai][1][m - 1][1]) :: "memory");
            }
        asm volatile("s_waitcnt lgkmcnt(0)" ::: "memory"); __builtin_amdgcn_s_barrier(); asm volatile("" ::: "memory");
        const int tid = wid * 64 + lane;
        unsigned* pc = cnt + 64 * u.pm;
        if (tid < 256) {
            const f32x4 p = *(const LAS f32x4*)(P + tid * 4);
            const float tot = (p[0] + p[1]) + (p[2] + p[3]);
            __hip_atomic_store(slots + ((size_t)(u.pm * 256 + tid) * 4 + u.pn), tot, __ATOMIC_RELAXED, __HIP_MEMORY_SCOPE_AGENT);
            asm volatile("s_waitcnt vmcnt(0)" ::: "memory");
            if (lane == 0) __hip_atomic_fetch_add(pc, 1u, __ATOMIC_RELAXED, __HIP_MEMORY_SCOPE_AGENT);
        }
        if (wid == 0) {
            unsigned spins = 0;
            while ((unsigned)__builtin_amdgcn_readfirstlane(__hip_atomic_load(pc, __ATOMIC_RELAXED, __HIP_MEMORY_SCOPE_AGENT)) < 16u) { __builtin_amdgcn_s_sleep(2); if (++spins > (1u << 24)) break; }
            __builtin_amdgcn_fence(__ATOMIC_ACQUIRE, "agent");
        }
        asm volatile("s_waitcnt vmcnt(0) lgkmcnt(0)" ::: "memory"); __builtin_amdgcn_s_barrier(); asm volatile("" ::: "memory");
        if (tid < 256) {
            const float* sl = slots + (size_t)(u.pm * 256 + tid) * 4;
            const float a0 = __hip_atomic_load(sl + 0, __ATOMIC_RELAXED, __HIP_MEMORY_SCOPE_AGENT), a1 = __hip_atomic_load(sl + 1, __ATOMIC_RELAXED, __HIP_MEMORY_SCOPE_AGENT);
            const float a2 = __hip_atomic_load(sl + 2, __ATOMIC_RELAXED, __HIP_MEMORY_SCOPE_AGENT), a3 = __hip_atomic_load(sl + 3, __ATOMIC_RELAXED, __HIP_MEMORY_SCOPE_AGENT);
            S[tid] = 1.0f / sqrtf(((a0 + a1) + (a2 + a3)) * (1.0f / 1024.0f) + EPS);
        }
        asm volatile("s_waitcnt vmcnt(0) lgkmcnt(0)" ::: "memory"); __builtin_amdgcn_s_barrier(); asm volatile("" ::: "memory");
        f32x4 gn[2][2];
#pragma unroll
        for (int bj = 0; bj < 2; ++bj)
#pragma unroll
            for (int n = 0; n < 2; ++n) gn[bj][n] = *(const f32x4*)(gain + col0 + bj * 128 + n * 16);
#pragma unroll
        for (int ai = 0; ai < 2; ++ai)
#pragma unroll
            for (int m = 0; m < 4; ++m) {
                const int rl = ai * 128 + wr * 64 + m * 16 + fr; const float r = S[rl]; const size_t ro = (size_t)(u.pm * 256 + rl) * 1024 + col0;
#pragma unroll
                for (int bj = 0; bj < 2; ++bj)
#pragma unroll
                    for (int n = 0; n < 2; ++n) __builtin_nontemporal_store(acc[ai][bj][m][n] * r * gn[bj][n], (f32x4*)(out + ro + bj * 128 + n * 16));
            }
    }
};

__device__ __forceinline__ void transpose_item(const float* W, int N, bf16_t* WT, int ldk, int kofs, int dst_row0, LAS float* scr, int k0, int n0, int lane) {
#pragma unroll 8
    for (int i = 0; i < 32; ++i) { const int kk = 2 * i + (lane >> 5); scr[kk * 33 + (lane & 31)] = W[(size_t)(k0 + kk) * N + n0 + (lane & 31)]; }
    asm volatile("s_waitcnt lgkmcnt(0)" ::: "memory");
    const int c = lane & 7;
#pragma unroll
    for (int j = 0; j < 4; ++j) { const int n = (lane >> 3) + 8 * j; const LAS float* s = scr + (8 * c) * 33 + n;
        u32x4 o; o.x = pk_bf16(s[0 * 33], s[1 * 33]); o.y = pk_bf16(s[2 * 33], s[3 * 33]); o.z = pk_bf16(s[4 * 33], s[5 * 33]); o.w = pk_bf16(s[6 * 33], s[7 * 33]);
        *(u32x4*)(WT + (size_t)(dst_row0 + n) * ldk + kofs + k0 + 8 * c) = o; }
    asm volatile("s_waitcnt lgkmcnt(0)" ::: "memory");
}
__device__ __forceinline__ int win_dst_row(int n0) {
    const int seg = n0 >> 10, within = n0 & 1023, j = within >> 7, i = within & 127;
    if (seg == 0) return 256 * j + i;
    if (seg == 2) return 256 * j + 128 + i;
    if (seg == 1) return 2048 + within;
    if (seg <= 6) return seg * 1024 + within;
    if (seg == 7) return 7168 + 256 * j + i;
    return 7168 + 256 * j + 128 + i;
}

constexpr int ATT_KBUF = 16384, ATT_VBUF = 20480, ATT_K0 = 0, ATT_V0 = 2 * ATT_KBUF, ATT_FLAGS = ATT_V0 + 2 * ATT_VBUF;
#ifndef SB_EARLY_EXIT
#define SB_EARLY_EXIT 1
#endif
__device__ __forceinline__ s16x4 tr16(const LAS unsigned char* p) { return __builtin_bit_cast(s16x4, __builtin_amdgcn_ds_read_tr16_b64_v4i16((LAS s16x4*)p)); }

__device__ __forceinline__ void att_tile(const LAS unsigned char* Kb, const LAS unsigned char* Vb, int t, int qw0, int myq, int hi, int kperm, unsigned vlane,
                                         const bf16x8 (&qf)[8], f32x16 (&o)[4], float& carry, bool walive) {
#pragma unroll
        for (int sbi = 0; sbi < 2; ++sbi) {
            const int sb = 1 - sbi; const int kb = 64 * t + 32 * sb;
            if (kb < qw0 + 31 && walive) {
                const int krow = 32 * sb + kperm; const int swz = (krow & 7) + 8 * ((krow >> 4) & 1);
                const LAS unsigned char* kp = Kb + krow * 256;
                f32x16 s;
#pragma unroll
                for (int r = 0; r < 16; ++r) s[r] = 0.f;
#pragma unroll
                for (int kk = 0; kk < 8; ++kk) { const bf16x8 a = *(const LAS bf16x8*)(kp + (((2 * kk + hi) ^ swz) * 16)); s = __builtin_amdgcn_mfma_f32_32x32x16_bf16(a, qf[kk], s, 0, 0, 0); }
                const bool needmask = (kb + 31 >= qw0);
                const int key0 = kb + 16 * hi;
                float wl[16]; float Ploc = 1.f;
                if (needmask) {
#pragma unroll
                    for (int r = 15; r >= 0; --r) {
                        float beta = rcpf_(1.f + ex2(-s[r]));
                        if (key0 + r >= myq) beta = 0.f;
                        wl[r] = beta * Ploc; Ploc -= wl[r];
                    }
                } else {
#pragma unroll
                    for (int r = 15; r >= 0; --r) { wl[r] = Ploc * rcpf_(1.f + ex2(-s[r])); Ploc -= wl[r]; }
                }
                const float Tother = __shfl_xor(Ploc, 32);
                const float cstart = carry * (hi == 0 ? Tother : 1.f);
                carry = carry * (Ploc * Tother);
                u32x4 w0, w1;
                w0.x = pk_bf16(wl[0] * cstart, wl[1] * cstart); w0.y = pk_bf16(wl[2] * cstart, wl[3] * cstart); w0.z = pk_bf16(wl[4] * cstart, wl[5] * cstart); w0.w = pk_bf16(wl[6] * cstart, wl[7] * cstart);
                w1.x = pk_bf16(wl[8] * cstart, wl[9] * cstart); w1.y = pk_bf16(wl[10] * cstart, wl[11] * cstart); w1.z = pk_bf16(wl[12] * cstart, wl[13] * cstart); w1.w = pk_bf16(wl[14] * cstart, wl[15] * cstart);
                const bf16x8 wb0 = __builtin_bit_cast(bf16x8, w0), wb1 = __builtin_bit_cast(bf16x8, w1);
                const LAS unsigned char* vp = Vb + (32 * sb) * 320 + vlane;
#pragma unroll
                for (int dt = 0; dt < 4; ++dt) {
                    const s16x4 a0 = tr16(vp + dt * 64), a1 = tr16(vp + 4 * 320 + dt * 64);
                    const s16x4 c0 = tr16(vp + 8 * 320 + dt * 64), c1 = tr16(vp + 12 * 320 + dt * 64);
                    const bf16x8 fa = __builtin_shufflevector(a0, a1, 0, 1, 2, 3, 4, 5, 6, 7), fc = __builtin_shufflevector(c0, c1, 0, 1, 2, 3, 4, 5, 6, 7);
                    o[dt] = __builtin_amdgcn_mfma_f32_32x32x16_bf16(fa, wb0, o[dt], 0, 0, 0);
                    o[dt] = __builtin_amdgcn_mfma_f32_32x32x16_bf16(fc, wb1, o[dt], 0, 0, 0);
                }
            }
        }
}

__device__ __forceinline__ void attn_unit(LAS unsigned char* lds, int b, int h, int qt, bf16_t* YAB, const bf16_t* KB, const bf16_t* VB, const bf16_t* ZB, bool do_store) {
    const int tid = threadIdx.x, lane = tid & 63, wid = __builtin_amdgcn_readfirstlane(tid >> 6), r32 = lane & 31, hi = lane >> 5;
    const int tok0 = b * SEQ, q0 = qt * 256, qw0 = q0 + 32 * wid, myq = qw0 + r32;
    bf16x8 qf[8];
    { const bf16_t* qp = YAB + (size_t)(tok0 + myq) * 2048 + 1024 + h * HD + 8 * hi;
#pragma unroll
      for (int kk = 0; kk < 8; ++kk) qf[kk] = *(const bf16x8*)(qp + 16 * kk); }
    const int skey0 = tid >> 4, sc0 = tid & 15; const int sswz = (skey0 & 7) + 8 * ((skey0 >> 4) & 1);
    const unsigned kdst0 = (unsigned)(skey0 * 256 + ((sc0 ^ sswz) * 16)), vdst0 = (unsigned)(skey0 * 320 + sc0 * 16);
    const bf16_t* kg = KB + (size_t)tok0 * 1024 + h * HD; const bf16_t* vg = VB + (size_t)tok0 * 1024 + h * HD;
    u32x4 kA[2], vA[2], kB[2], vB[2];
    const int T0 = qt * 4 + 3;
#define ATT_LOAD(KR, VR, tile) do { _Pragma("unroll") for (int i = 0; i < 2; ++i) { const size_t go = (size_t)(64 * (tile) + skey0 + 32 * i) * 1024 + 8 * sc0; KR[i] = *(const u32x4*)(kg + go); VR[i] = *(const u32x4*)(vg + go); } } while (0)
#define ATT_WRITE(KR, VR, buf) do { _Pragma("unroll") for (int i = 0; i < 2; ++i) { *(LAS u32x4*)(lds + ATT_K0 + (buf) * ATT_KBUF + kdst0 + 8192 * i) = KR[i]; *(LAS u32x4*)(lds + ATT_V0 + (buf) * ATT_VBUF + vdst0 + 10240 * i) = VR[i]; } } while (0)
    ATT_LOAD(kA, vA, T0); ATT_LOAD(kB, vB, T0 - 1);
    ATT_WRITE(kA, vA, 0);
    __syncthreads();
    f32x16 o[4];
#pragma unroll
    for (int d = 0; d < 4; ++d)
#pragma unroll
        for (int r = 0; r < 16; ++r) o[d][r] = 0.f;
    float carry = 1.f; bool walive = true;
    const int kperm = 16 * ((r32 >> 2) & 1) + (r32 & 3) + 4 * (r32 >> 3);
    const int i16 = lane & 15, qd = i16 >> 2, pp = i16 & 3, blk = (lane >> 4) & 1;
    const unsigned vlane = (unsigned)((16 * hi + qd) * 320 + (16 * blk + 4 * pp) * 2);
    int cur = 0; int it = 0; int t = T0;
#define ATT_STEP(KF, VF, KH, VH) { \
        if (t >= 2) ATT_LOAD(KF, VF, t - 2); \
        att_tile(lds + ATT_K0 + cur * ATT_KBUF, lds + ATT_V0 + cur * ATT_VBUF, t, qw0, myq, hi, kperm, vlane, qf, o, carry, walive); \
        if (t >= 1) ATT_WRITE(KH, VH, cur ^ 1); \
        walive = __any(carry > 0x1p-134f);     \
        if (lane == 0) ((LAS unsigned*)(lds + ATT_FLAGS))[(it & 1) * 8 + wid] = walive ? 1u : 0u; \
        __syncthreads(); \
        { const LAS unsigned* fl = (const LAS unsigned*)(lds + ATT_FLAGS) + (it & 1) * 8; \
          const unsigned any = fl[0] | fl[1] | fl[2] | fl[3] | fl[4] | fl[5] | fl[6] | fl[7]; \
          if (any == 0u || t == 0) break; }     \
        --t; cur ^= 1; ++it; }
    for (;;) {
        ATT_STEP(kA, vA, kB, vB)
        ATT_STEP(kB, vB, kA, vA)
    }
#undef ATT_STEP
#undef ATT_LOAD
#undef ATT_WRITE
    { const bf16_t* zp = ZB + (size_t)(tok0 + myq) * 1024 + h * HD + 8 * hi; bf16_t* op = YAB + (size_t)(tok0 + myq) * 2048 + 1024 + h * HD + 8 * hi;
#pragma unroll
      for (int dt = 0; dt < 4; ++dt)
#pragma unroll
          for (int p = 0; p < 2; ++p) {
              const u32x4 z = *(const u32x4*)(zp + 32 * dt + 16 * p);
              float v[8];
#pragma unroll
              for (int j = 0; j < 4; ++j) {
                  const auto rr = __builtin_amdgcn_permlane32_swap(__float_as_uint(o[dt][8 * p + j]), __float_as_uint(o[dt][8 * p + 4 + j]), false, false);
                  v[j] = __uint_as_float(rr[0]); v[4 + j] = __uint_as_float(rr[1]);
              }
              u32x4 w; w.x = pk_bf16(v[0] * bf_lo(z.x), v[1] * bf_hi(z.x)); w.y = pk_bf16(v[2] * bf_lo(z.y), v[3] * bf_hi(z.y));
              w.z = pk_bf16(v[4] * bf_lo(z.z), v[5] * bf_hi(z.z)); w.w = pk_bf16(v[6] * bf_lo(z.w), v[7] * bf_hi(z.w));
              if (do_store) *(u32x4*)(op + 32 * dt + 16 * p) = w;
          } }
}

constexpr int GM_V = 0, GM_RSTD = 40960, GM_STG = 41472, GM_STGP = 132;
__device__ __forceinline__ void gmlp_phase(LAS unsigned char* lds, int cu, int G, bf16_t* YAB, const bf16_t* VA, const float* ssv, const float* w_s, const float* b_s, const float* norm_v) {
    const int tid = threadIdx.x, lane = tid & 63, wid = __builtin_amdgcn_readfirstlane(tid >> 6), r32 = lane & 31, hi = lane >> 5;
    const int ttile = wid & 3, chalf = wid >> 2; const int t = 32 * ttile + r32;
    const bool fixg = (G & 7) == 0;
    const int nun = fixg ? (512 - (cu >> 3) + (G >> 3) - 1) / (G >> 3) : (4096 - cu + G - 1) / G;
    if (nun <= 0) return;
#define GM_UNIT(i, p_, g_) do { if (fixg) { p_ = (cu >> 3) + (G >> 3) * (i); g_ = cu & 7; } else { const int v_ = cu + G * (i); p_ = v_ >> 3; g_ = v_ & 7; } } while (0)
    u32x4 vld[4], uzC[4]; f32x4 ssl[4];
    f32x4 wa[8], wb[8], bs[4]; float nv[2]; int gcur = -1;
#define GM_LOADS(p_, g_) do { const int tok_ = ((p_) >> 4) * SEQ + ((p_) & 15) * CHUNK; \
        _Pragma("unroll") for (int i = 0; i < 4; ++i) { const int id = tid + 512 * i, s_ = id >> 4, c_ = id & 15; \
            vld[i] = *(const u32x4*)(VA + (size_t)(tok_ + s_) * 1024 + (g_) * 128 + 8 * c_); } \
        if (tid < 128) { const f32x4* p4 = (const f32x4*)(ssv + (size_t)(tok_ + tid) * 16); ssl[0] = p4[0]; ssl[1] = p4[1]; ssl[2] = p4[2]; ssl[3] = p4[3]; } } while (0)
    int p, g; GM_UNIT(0, p, g);
    GM_LOADS(p, g);
    const int i16 = lane & 15, qd = i16 >> 2, pp = i16 & 3, blk = (lane >> 4) & 1;
    const LAS unsigned char* vp = lds + GM_V + (8 * hi + qd) * 320 + (64 * chalf + 16 * blk + 4 * pp) * 2;
    const LAS float* rs = (const LAS float*)(lds + GM_RSTD);
    const int nks = 2 * (ttile + 1);
    for (int iu = 0; iu < nun; ++iu) {
        const int tok0 = (p >> 4) * SEQ + (p & 15) * CHUNK;
        if (g != gcur) {
            const float* wrow = w_s + ((size_t)g * 128 + t) * 128 + 8 * hi;
#pragma unroll
            for (int kk = 0; kk < 8; ++kk) { wa[kk] = *(const f32x4*)(wrow + 16 * kk); wb[kk] = *(const f32x4*)(wrow + 16 * kk + 4); }
#pragma unroll
            for (int ct = 0; ct < 2; ++ct) nv[ct] = norm_v[g * 128 + 64 * chalf + 32 * ct + r32];
#pragma unroll
            for (int g4 = 0; g4 < 4; ++g4) bs[g4] = *(const f32x4*)(b_s + g * 128 + 32 * ttile + 8 * g4 + 4 * hi);
            gcur = g;
        }
#pragma unroll
        for (int i = 0; i < 4; ++i) { const int id = tid + 512 * i, s_ = id >> 4, c_ = id & 15; *(LAS u32x4*)(lds + GM_V + s_ * 320 + c_ * 16) = vld[i]; }
        if (tid < 128) {
            const float sum = ((ssl[0][0] + ssl[0][1]) + (ssl[0][2] + ssl[0][3])) + ((ssl[1][0] + ssl[1][1]) + (ssl[1][2] + ssl[1][3])) + ((ssl[2][0] + ssl[2][1]) + (ssl[2][2] + ssl[2][3])) + ((ssl[3][0] + ssl[3][1]) + (ssl[3][2] + ssl[3][3]));
            ((LAS float*)(lds + GM_RSTD))[tid] = 1.0f / sqrtf(sum * (1.0f / 1024.0f) + EPS); }
        __syncthreads();
        int pn_ = p, gn_ = g;
#pragma unroll
        for (int i = 0; i < 4; ++i) { const int id = tid + 512 * i, s_ = id >> 4, c_ = id & 15; uzC[i] = *(const u32x4*)(YAB + (size_t)(tok0 + s_) * 2048 + g * 128 + 8 * c_); }
        if (iu + 1 < nun) { GM_UNIT(iu + 1, pn_, gn_); GM_LOADS(pn_, gn_); }
        f32x16 acc[2];
#pragma unroll
        for (int ct = 0; ct < 2; ++ct)
#pragma unroll
            for (int r = 0; r < 16; ++r) acc[ct][r] = 0.f;
#pragma unroll
        for (int kk = 0; kk < 8; ++kk) {
            if (kk < nks) {
                const int s0 = 16 * kk + 8 * hi;
                const f32x4 ra = *(const LAS f32x4*)(rs + s0), rb = *(const LAS f32x4*)(rs + s0 + 4);
                float a8[8];
#pragma unroll
                for (int j = 0; j < 4; ++j) { a8[j] = (s0 + j <= t) ? wa[kk][j] * ra[j] : 0.f; a8[4 + j] = (s0 + 4 + j <= t) ? wb[kk][j] * rb[j] : 0.f; }
                u32x4 aw; aw.x = pk_bf16(a8[0], a8[1]); aw.y = pk_bf16(a8[2], a8[3]); aw.z = pk_bf16(a8[4], a8[5]); aw.w = pk_bf16(a8[6], a8[7]);
                const bf16x8 af = __builtin_bit_cast(bf16x8, aw);
#pragma unroll
                for (int ct = 0; ct < 2; ++ct) {
                    const s16x4 lo = tr16(vp + (16 * kk) * 320 + ct * 64), hi4 = tr16(vp + (16 * kk + 4) * 320 + ct * 64);
                    const bf16x8 bfr = __builtin_shufflevector(lo, hi4, 0, 1, 2, 3, 4, 5, 6, 7);
                    acc[ct] = __builtin_amdgcn_mfma_f32_32x32x16_bf16(af, bfr, acc[ct], 0, 0, 0);
                }
            }
        }
        { LAS float* stg = (LAS float*)(lds + GM_STG);
#pragma unroll
          for (int ct = 0; ct < 2; ++ct) { const int c = 64 * chalf + 32 * ct + r32;
#pragma unroll
              for (int g4 = 0; g4 < 4; ++g4) { const int tb = 32 * ttile + 8 * g4 + 4 * hi;
#pragma unroll
                  for (int j = 0; j < 4; ++j) stg[(tb + j) * GM_STGP + c] = acc[ct][4 * g4 + j] * nv[ct] + bs[g4][j]; } } }
        __syncthreads();
#pragma unroll
        for (int i = 0; i < 4; ++i) { const int id = tid + 512 * i, tt = id >> 4, cc = id & 15;
            const LAS float* sp = (const LAS float*)(lds + GM_STG) + tt * GM_STGP + 8 * cc; const f32x4 m0 = *(const LAS f32x4*)sp, m1 = *(const LAS f32x4*)(sp + 4);
            bf16_t* gp = YAB + (size_t)(tok0 + tt) * 2048 + g * 128 + 8 * cc; const u32x4 uz = uzC[i];
            u32x4 w; w.x = pk_bf16(bf_lo(uz.x) * m0[0], bf_hi(uz.x) * m0[1]); w.y = pk_bf16(bf_lo(uz.y) * m0[2], bf_hi(uz.y) * m0[3]);
            w.z = pk_bf16(bf_lo(uz.z) * m1[0], bf_hi(uz.z) * m1[1]); w.w = pk_bf16(bf_lo(uz.w) * m1[2], bf_hi(uz.w) * m1[3]);
            *(u32x4*)gp = w; }
        __syncthreads();
        p = pn_; g = gn_;
    }
#undef GM_UNIT
#undef GM_LOADS
}


#define XB_TMO      128
#define XB_XCNT(j)  (256  + 64 * (j))
#define XB_XSUB(j)  (1280 + 64 * (j))
#define XB_XGEN(j)  (2304 + 64 * (j))
#define XB_TOP      3328
#define XB_TOPGEN   3392
#define XCD_BAR_WORDS 3456
#define XB_SPIN_CAP (1u << 18)
__device__ __forceinline__ unsigned xb_ld(unsigned* p)              { return __hip_atomic_load(p, __ATOMIC_RELAXED, __HIP_MEMORY_SCOPE_AGENT); }
__device__ __forceinline__ unsigned xb_add(unsigned* p, unsigned v) { return __hip_atomic_fetch_add(p, v, __ATOMIC_RELAXED, __HIP_MEMORY_SCOPE_AGENT); }
__device__ __forceinline__ unsigned xb_xcc_id() { return (unsigned)__builtin_amdgcn_s_getreg((3 << 11) | 20) & 0xFu; }
#define XB_SPIN(cond, bar) do { unsigned _sp = 0; while (cond) { __builtin_amdgcn_s_sleep(1); \
    if ((++_sp & 255u) == 0u) { if (xb_ld(&(bar)[XB_TMO])) break; if (_sp > XB_SPIN_CAP) { atomicAdd(&(bar)[XB_TMO], 1u); break; } } } } while (0)
struct XcdBarrier { unsigned* bar; unsigned x; volatile LAS unsigned* st; };
__device__ __forceinline__ XcdBarrier xcd_barrier_post(unsigned* bar, volatile LAS unsigned* st) {
    XcdBarrier b; b.bar = bar; b.x = xb_xcc_id(); b.st = st;
    if (threadIdx.x == 0) (void)xb_add(&bar[XB_XCNT(b.x)], 1u);
    return b;
}
__device__ __forceinline__ void xcd_barrier_complete(unsigned* bar, unsigned x, unsigned& nloc, unsigned& nx) {
    const unsigned G = gridDim.x * gridDim.y * gridDim.z;
    unsigned sum, cnt, mine, sp = 0u;
    for (;;) {
        sum = 0u; cnt = 0u; mine = 0u;
#pragma unroll
        for (unsigned j = 0; j < 16; ++j) { const unsigned c = xb_ld(&bar[XB_XCNT(j)]); sum += c; cnt += (c > 0u) ? 1u : 0u; mine = (j == x) ? c : mine; }
        if (sum == G) break;
        __builtin_amdgcn_s_sleep(1);
        if ((++sp & 255u) == 0u) { if (xb_ld(&bar[XB_TMO])) break; if (sp > XB_SPIN_CAP) { atomicAdd(&bar[XB_TMO], 1u); break; } }
    }
    nloc = mine > 0u ? mine : 1u; nx = cnt > 0u ? cnt : 1u;
}
__device__ __forceinline__ void xcd_barrier(unsigned* bar_, volatile LAS unsigned* st_) {
    asm volatile("s_waitcnt vmcnt(0)" ::: "memory");
    __syncthreads();
    if (threadIdx.x == 0) {
        XcdBarrier b; b.bar = bar_; b.x = xb_xcc_id(); b.st = st_;
        unsigned* bar = b.bar;
        __builtin_amdgcn_s_waitcnt(0);
        unsigned nloc = b.st[0], nx = b.st[1];
        if (nloc == 0u) { xcd_barrier_complete(bar, b.x, nloc, nx); b.st[0] = nloc; b.st[1] = nx; }
        const unsigned old = xb_add(&bar[XB_XSUB(b.x)], 1u);
        const unsigned gen = old / nloc;
        if (old + 1u == (gen + 1u) * nloc) {
            __builtin_amdgcn_fence(__ATOMIC_RELEASE, "agent");
            asm volatile("s_waitcnt vmcnt(0)" ::: "memory");
            const unsigned og = xb_add(&bar[XB_TOP], 1u);
            const unsigned tg = og / nx;
            if (og + 1u == (tg + 1u) * nx) xb_add(&bar[XB_TOPGEN], 1u);
            else XB_SPIN(xb_ld(&bar[XB_TOPGEN]) == tg, bar);
            __builtin_amdgcn_fence(__ATOMIC_ACQUIRE, "agent");
            xb_add(&bar[XB_XGEN(b.x)], 1u);
            asm volatile("s_waitcnt vmcnt(0)" ::: "memory");
        } else {
            XB_SPIN(xb_ld(&bar[XB_XGEN(b.x)]) == gen, bar);
            __builtin_amdgcn_fence(__ATOMIC_ACQUIRE, "agent");
            asm volatile("s_waitcnt vmcnt(0)" ::: "memory");
        }
    }
    __syncthreads();
}

struct Args { const float* in[10]; float* out; unsigned char* ws; };
#ifndef PHM
#define PHM 31
#endif
#ifndef ATT_REP
#define ATT_REP 1
#endif
#ifndef GM_REP
#define GM_REP 1
#endif
#ifndef REP0
#define REP0 1
#endif
#ifndef REP1
#define REP1 1
#endif
#ifndef REP3
#define REP3 1
#endif
#ifndef REP4
#define REP4 1
#endif
#ifndef P2M
#define P2M 3
#endif
constexpr int N_ATT = BATCH * NH * (SEQ / 256), N_GM = BATCH * (SEQ / CHUNK) * NG;

__global__ void __launch_bounds__(512, 2) fwd_megakernel(Args args) {
    extern __shared__ __attribute__((aligned(16))) unsigned char lds_raw[];
    LAS unsigned char* lds = (LAS unsigned char*)lds_raw;
    cg::grid_group grid = cg::this_grid();
    const int tid = threadIdx.x, lane = tid & 63, wave = __builtin_amdgcn_readfirstlane(tid >> 6);
    const int G = gridDim.x;
    const float* x = args.in[0]; const float* norm_in = args.in[1]; const float* w_in = args.in[2]; const float* norm_v = args.in[3]; const float* w_s = args.in[4];
    const float* b_s = args.in[5]; const float* w_o_gmlp = args.in[6]; const float* w_o_sb = args.in[7]; const float* w_out = args.in[8]; const float* norm_final = args.in[9];
    unsigned char* ws = args.ws; float* out = args.out;
    unsigned* ctl = (unsigned*)(ws + WS_CTL);
    volatile LAS unsigned* xst = (volatile LAS unsigned*)(lds + LDS_MISC + 64);
    if (tid < 2) xst[tid] = 0u;
    __syncthreads();
    for (unsigned w = blockIdx.x * 512u + tid; w < CTL_BYTES / 4; w += gridDim.x * 512u) ctl[w] = 0u;
    bf16_t* WIN = (bf16_t*)(ws + WS_WIN); bf16_t* WCAT = (bf16_t*)(ws + WS_WCAT); bf16_t* WOUT = (bf16_t*)(ws + WS_WOUT);
    float* ssv = (float*)(ws + WS_SSV); float* ssf = (float*)(ws + WS_SSF);
    bf16_t* YAB = (bf16_t*)(ws + WS_YAB); bf16_t* VA = (bf16_t*)(ws + WS_VA); bf16_t* VB = (bf16_t*)(ws + WS_VB); bf16_t* ZB = (bf16_t*)(ws + WS_ZB);
    bf16_t* GA = (bf16_t*)(ws + WS_GA); bf16_t* GB = (bf16_t*)(ws + WS_GB); bf16_t* MG = VA;
    bf16_t* XN = (bf16_t*)out; bf16_t* KB = (bf16_t*)out + (size_t)M * 1024;

    for (int rep_ = 0; rep_ < REP0; ++rep_) {
        LAS float* scr = (LAS float*)(lds + wave * 16384);
        const int gw = blockIdx.x * 8 + wave, NGW = G * 8;
        constexpr int I_IN = 16 * (NIN / 32), I_SQ = 16 * 32;
        for (int it = gw; it < I_IN + 3 * I_SQ; it += NGW) {
            int r = it;
            if (r < I_IN) { const int kb = r / (NIN / 32), nb = r % (NIN / 32); transpose_item(w_in, NIN, WIN, 1024, 0, win_dst_row(32 * nb), scr, 64 * kb, 32 * nb, lane); continue; }
            r -= I_IN; const int which = r / I_SQ; r -= which * I_SQ; const int kb = r / 32, nb = r % 32;
            if (which == 0) transpose_item(w_o_gmlp, 1024, WCAT, 2048, 0, 32 * nb, scr, 64 * kb, 32 * nb, lane);
            else if (which == 1) transpose_item(w_o_sb, 1024, WCAT, 2048, 1024, 32 * nb, scr, 64 * kb, 32 * nb, lane);
            else transpose_item(w_out, 1024, WOUT, 1024, 0, 32 * nb, scr, 64 * kb, 32 * nb, lane);
        }
        f32x4 gn[4];
#pragma unroll
        for (int j = 0; j < 4; ++j) gn[j] = *((const f32x4*)norm_in + lane + 64 * j);
        for (int m = gw; m < M; m += 4 * NGW) {
            f32x4 v[4][4]; float sq[4];
#pragma unroll
            for (int q = 0; q < 4; ++q) { const int mq = (m + q * NGW < M) ? m + q * NGW : m; const f32x4* xr = (const f32x4*)(x + (size_t)mq * DM) + lane;
#pragma unroll
                for (int j = 0; j < 4; ++j) v[q][j] = xr[64 * j]; }
#pragma unroll
            for (int q = 0; q < 4; ++q) { float a = 0.f;
#pragma unroll
                for (int j = 0; j < 4; ++j) a += (v[q][j][0] * v[q][j][0] + v[q][j][1] * v[q][j][1]) + (v[q][j][2] * v[q][j][2] + v[q][j][3] * v[q][j][3]);
                sq[q] = a; }
#pragma unroll
            for (int o = 1; o < 64; o <<= 1) {
#pragma unroll
                for (int q = 0; q < 4; ++q) sq[q] += __shfl_xor(sq[q], o); }
#pragma unroll
            for (int q = 0; q < 4; ++q) if (m + q * NGW < M) {
                const float r = 1.0f / sqrtf(sq[q] * (1.0f / DM) + EPS);
                u32x2* o8 = (u32x2*)(XN + (size_t)(m + q * NGW) * DM) + lane;
#pragma unroll
                for (int j = 0; j < 4; ++j) { u32x2 w; w.x = pk_bf16(v[q][j][0] * r * gn[j][0], v[q][j][1] * r * gn[j][1]); w.y = pk_bf16(v[q][j][2] * r * gn[j][2], v[q][j][3] * r * gn[j][3]); o8[64 * j] = w; }
            }
        }
    }
    grid.sync();
    (void)xcd_barrier_post(ctl + 20480, xst);

    {
        pg8::Gemm g{XN, WIN, M, NIN, DM}; pg8::StaticOrder S; S.init(M, NIN, G, (int)blockIdx.x, REP1, KDUP);
        EpiP1 E{YAB, VA, KB, VB, ZB, GA, GB, ssv, (LAS float*)(lds + LDS_MISC + 1024)};
        pg8::gemm_phase<EpiP1, pg8::StaticOrder>(lds, g, S, E);
    }
    xcd_barrier((unsigned*)((unsigned char*)args.ws + WS_CTL) + 20480, (volatile LAS unsigned*)(lds + LDS_MISC + 64));

    if (PHM & 4) {
        const bool gfirst = (((int)blockIdx.x >> 3) & 1) != 0;
        if (gfirst) { gmlp_phase(lds, (int)blockIdx.x, G, YAB, VA, ssv, w_s, b_s, norm_v); __syncthreads(); }
        LAS int* uw = (LAS int*)(lds + LDS_MISC);
        if (tid == 0) uw[0] = (int)atomicAdd(ctl + 0, 1u);
        __syncthreads();
        int u = uw[0];
        for (int k = 0; u < N_ATT; ++k) {
            int unext = 0;
            if (tid == 0) unext = (int)atomicAdd(ctl + 0, 1u);
            {
                const int cls = 3 - (u >> 9), r = u & 511; const int qt = 7 - (r >> 6), j = r & 63; const int b = 4 * (j >> 3) + cls, h = j & 7;
                attn_unit(lds, b, h, qt, YAB, KB, VB, ZB, true); }
            if (tid == 0) uw[(k + 1) & 1] = unext;
            __syncthreads();
            u = uw[(k + 1) & 1];
        }
        __syncthreads();
        if (!gfirst) gmlp_phase(lds, (int)blockIdx.x, G, YAB, VA, ssv, w_s, b_s, norm_v);
    }
    xcd_barrier((unsigned*)((unsigned char*)args.ws + WS_CTL) + 20480, (volatile LAS unsigned*)(lds + LDS_MISC + 64));

    {
        pg8::Gemm g{YAB, WCAT, M, DM, 2048}; pg8::StaticOrder S; S.init(M, DM, G, (int)blockIdx.x, REP3);
        EpiP3 E{GA, GB, MG};
        pg8::gemm_phase<EpiP3, pg8::StaticOrder>(lds, g, S, E);
    }
    xcd_barrier((unsigned*)((unsigned char*)args.ws + WS_CTL) + 20480, (volatile LAS unsigned*)(lds + LDS_MISC + 64));

    {
        pg8::Gemm g{MG, WOUT, M, DM, DM}; pg8::StaticOrder S; S.init(M, DM, G, (int)blockIdx.x, REP4);
        EpiP4 E{x, out, norm_final, ssf, ctl + 1024};
        pg8::gemm_phase<EpiP4, pg8::StaticOrder>(lds, g, S, E);
    }
}

extern "C" void kernel_launch(void* const* d_in, const int* in_sizes, int n_in, void* d_out, int out_size, void* d_ws, size_t ws_size, hipStream_t stream) {
    static int grid_blocks = 0;
    if (grid_blocks == 0) {
        if (n_in != 10 || in_sizes[0] != M * DM || out_size != M * DM || ws_size < WS_END) { fprintf(stderr, "kernel_launch: unexpected shapes / workspace (%d inputs, ws %zu)\n", n_in, ws_size); grid_blocks = -1; return; }
        int dev = 0, cus = 0, per_cu = 0;
        hipGetDevice(&dev); hipDeviceGetAttribute(&cus, hipDeviceAttributeMultiprocessorCount, dev);
        hipFuncSetAttribute((const void*)fwd_megakernel, hipFuncAttributeMaxDynamicSharedMemorySize, LDS_BYTES);
        hipOccupancyMaxActiveBlocksPerMultiprocessor(&per_cu, (const void*)fwd_megakernel, 512, LDS_BYTES);
        if (per_cu < 1) per_cu = 1;
        grid_blocks = cus * per_cu;
        (void)hipGetLastError();
    }
    if (grid_blocks < 0) return;
    Args a{};
    for (int i = 0; i < 10; ++i) a.in[i] = (const float*)d_in[i];
    a.out = (float*)d_out; a.ws = (unsigned char*)d_ws;
    void* kargs[] = {&a};
    hipError_t e = hipLaunchCooperativeKernel((const void*)fwd_megakernel, dim3(grid_blocks), dim3(512), kargs, LDS_BYTES, stream);
    if (e != hipSuccess) fprintf(stderr, "cooperative launch failed: %s (grid %d)\n", hipGetErrorString(e), grid_blocks);
}
```

```cpp
#include <hip/hip_runtime.h>
#include <hip/hip_cooperative_groups.h>
#include <cstdio>
#include <cstdint>
namespace cg = cooperative_groups;

#define LAS __attribute__((address_space(3)))
#define GAS __attribute__((address_space(1)))
typedef unsigned short bf16_t;
typedef short bf16x8 __attribute__((ext_vector_type(8)));
typedef short s16x4 __attribute__((ext_vector_type(4)));
typedef float f32x4 __attribute__((ext_vector_type(4)));
typedef float f32x2 __attribute__((ext_vector_type(2)));
typedef float f32x16 __attribute__((ext_vector_type(16)));
typedef unsigned u32x4 __attribute__((ext_vector_type(4)));
typedef unsigned u32x2 __attribute__((ext_vector_type(2)));
typedef __bf16 bf16x2_t __attribute__((ext_vector_type(2)));

constexpr int DM = 1024, BATCH = 32, SEQ = 2048, M = BATCH * SEQ;
constexpr int NIN = 9216, NH = 8, HD = 128, CHUNK = 128, NG = 8;
constexpr float EPS = 1e-6f;
constexpr float LOG2E = 1.4426950408889634f;

constexpr size_t MiB = 1u << 20;
constexpr size_t WS_CTL = 0, CTL_BYTES = 131072;
constexpr size_t WS_WIN = 2 * MiB, WS_WCAT = 20 * MiB, WS_WOUT = 24 * MiB, WS_SSV = 26 * MiB, WS_SSF = 30 * MiB;
constexpr size_t WS_YAB = 64 * MiB, WS_VA = 320 * MiB, WS_VB = 448 * MiB, WS_ZB = 576 * MiB, WS_GA = 704 * MiB, WS_GB = 832 * MiB, WS_END = 960 * MiB;
constexpr int LDS_RING = 131072, LDS_MISC = 131072, LDS_BYTES = 147456;

__device__ __forceinline__ float ex2(float x) { return __builtin_amdgcn_exp2f(x); }
__device__ __forceinline__ float rcpf_(float x) { return __builtin_amdgcn_rcpf(x); }
__device__ __forceinline__ unsigned pk_bf16(float lo, float hi) { f32x2 v = {lo, hi}; bf16x2_t b = __builtin_convertvector(v, bf16x2_t); return __builtin_bit_cast(unsigned, b); }
__device__ __forceinline__ float bf_lo(unsigned w) { return __uint_as_float(w << 16); }
__device__ __forceinline__ float bf_hi(unsigned w) { return __uint_as_float(w & 0xffff0000u); }
__device__ __forceinline__ float sigmoidf_(float x) { return rcpf_(1.f + ex2(-x * LOG2E)); }
constexpr float GC0 = -1.5957691216057308f * LOG2E, GC1 = -1.5957691216057308f * 0.044715f * LOG2E;
__device__ __forceinline__ float gelu_e(float x) { return ex2(x * (GC0 + GC1 * (x * x))); }
__device__ __forceinline__ float gelu_tanh(float x) { return x * rcpf_(1.f + gelu_e(x)); }
__device__ __forceinline__ float siluf_(float x) { return x * sigmoidf_(x); }
__device__ __forceinline__ float xsum_fq(float v) {
    const auto a = __builtin_amdgcn_permlane16_swap(__float_as_uint(v), __float_as_uint(v), false, false);
    const float t = __uint_as_float(a[0]) + __uint_as_float(a[1]);
    const auto b = __builtin_amdgcn_permlane32_swap(__float_as_uint(t), __float_as_uint(t), false, false);
    return __uint_as_float(b[0]) + __uint_as_float(b[1]);
}
__device__ __forceinline__ float wave_sum(float v) {
#pragma unroll
    for (int o = 1; o < 64; o <<= 1) v += __shfl_xor(v, o);
    return v;
}

#ifndef KDUP
#define KDUP 1
#endif
namespace pg8 {
constexpr int BM = 256, BK = 64, HALF = 128, HTB = HALF * BK * 2, STAGE_BYTES = 8 * HTB, NXCD = 8, WGM = 8;
__host__ __device__ __forceinline__ int lds_byte(int r, int c) { const int st = (r >> 4) * 2 + (c >> 5), rr = r & 15, cc = c & 31, ob = rr * 64 + cc * 2; return st * 1024 + (ob ^ (((ob >> 9) & 1) << 5)); }
__host__ __device__ __forceinline__ void stage_rc(int b, int& R, int& C) { const int st = b / 1024, sb = b % 1024, swz = sb ^ (((sb >> 9) & 1) << 5); R = (st >> 1) * 16 + swz / 64; C = (st & 1) * 32 + (swz % 64) / 2; }
__host__ __device__ __forceinline__ int perm32(int rho) { const int n = rho >> 4, i = rho & 15; return 8 * (i >> 2) + 4 * n + (i & 3); }
struct Unit { int pm, pn; };
struct Gemm { const bf16_t* A; const bf16_t* Bt; int M, N, K; };
struct StaticOrder {
    int nM, nN, nwg, G, c, rep, dup;
    __device__ void init(int M_, int N_, int G_, int c_, int rep_ = 1, int dup_ = 1) { nM = M_ / BM; nN = N_ / BM; nwg = nM * nN; G = G_; c = c_; rep = rep_; dup = dup_; }
    __device__ bool next(int i, Unit& u) const {
        long L = (long)(i / dup) * G + c; if (L >= (long)nwg * rep) return false; L %= nwg;
        int wgid = (int)L; { const int q = nwg / NXCD, r = nwg % NXCD, xcd = wgid % NXCD, off = wgid / NXCD; wgid = (xcd < r ? xcd * (q + 1) : r * (q + 1) + (xcd - r) * q) + off; }
        const int nig = WGM * nN, gid = wgid / nig, fm = gid * WGM, gsz = (nM - fm) < WGM ? (nM - fm) : WGM;
        u.pm = fm + ((wgid % nig) % gsz); u.pn = (wgid % nig) / gsz; return true;
    }
};
struct PanelOrder {
    int nM, nN, G, c, rep;
    __device__ void init(int M_, int N_, int G_, int c_, int rep_ = 1) { nM = M_ / BM; nN = N_ / BM; G = G_; c = c_; rep = rep_; }
    __device__ bool next(int i, Unit& u) const { const int pm = c + G * (i / (nN * rep)); if (pm >= nM) return false; u.pm = pm; u.pn = i % nN; return true; }
};

template <class Epi, class Sched>
__device__ __forceinline__ void gemm_phase(LAS unsigned char* lds, const Gemm g, const Sched& S, const Epi& E) {
    const int tid = threadIdx.x, wid = __builtin_amdgcn_readfirstlane(tid >> 6), lane = tid & 63, wr = wid >> 2, wc = wid & 3, fr = lane & 15, fq = lane >> 4;
    const int K = g.K, nt = K / BK;
    unsigned voffA[2], voffB[2];
#pragma unroll
    for (int i = 0; i < 2; ++i) { int R, C; stage_rc(tid * 16 + i * 8192, R, C); const int Rb = Epi::PERM ? ((R & ~31) + perm32(R & 31)) : R;
        voffA[i] = (unsigned)(R * K + C) * 2u; voffB[i] = (unsigned)(Rb * K + C) * 2u; }
    const size_t kstep = (size_t)(BK * 2);
    const size_t hstep = (size_t)HALF * K * 2;
    const size_t tstep = 2 * hstep;
    const unsigned ldsw = (unsigned)wid * 1024u;
    const int aoff = lds_byte(wr * 64 + fr, fq * 8), boff = lds_byte(wc * 32 + fr, fq * 8);
#define PG8_SA(b, h) (((b) * 2 + (h)) * HTB)
#define PG8_SB(b, h) ((4 + (b) * 2 + (h)) * HTB)
#define PG8_STAGE(bufoff, gbase, voff) do { _Pragma("unroll") for (int _i = 0; _i < 2; ++_i) \
        __builtin_amdgcn_global_load_lds((const unsigned*)((const char*)(gbase) + (voff)[_i]), (LAS unsigned*)(lds + (bufoff) + ldsw + _i * 8192), 16, 0, 0); } while (0)
#define PG8_LDA(dst, b, h) do { _Pragma("unroll") for (int m = 0; m < 4; ++m) _Pragma("unroll") for (int k = 0; k < 2; ++k) dst[m][k] = *(const LAS bf16x8*)(lds + PG8_SA(b, h) + aoff + m * 2048 + k * 1024); } while (0)
#define PG8_LDB(dst, b, h) do { _Pragma("unroll") for (int n = 0; n < 2; ++n) _Pragma("unroll") for (int k = 0; k < 2; ++k) dst[n][k] = *(const LAS bf16x8*)(lds + PG8_SB(b, h) + boff + n * 2048 + k * 1024); } while (0)
#define PG8_MMA(ai, bj, At, Bt) do { __builtin_amdgcn_s_setprio(1); _Pragma("unroll") for (int m = 0; m < 4; ++m) _Pragma("unroll") for (int n = 0; n < 2; ++n) _Pragma("unroll") for (int k = 0; k < 2; ++k) \
        acc[ai][bj][m][n] = __builtin_amdgcn_mfma_f32_16x16x32_bf16(Bt[n][k], At[m][k], acc[ai][bj][m][n], 0, 0, 0); __builtin_amdgcn_s_setprio(0); } while (0)
#define PG8_WAIT_V(n) asm volatile("s_waitcnt vmcnt(" #n ")" ::: "memory")
#define PG8_WAIT_L(n) asm volatile("s_waitcnt lgkmcnt(" #n ")" ::: "memory")
#define PG8_BAR __builtin_amdgcn_s_barrier()
#define PG8_SCHED __builtin_amdgcn_sched_barrier(0)
#define PG8_KBODY(t) do { \
            const bool last = (t == nt - 2); \
            const char* a1 = cA + (size_t)(t + 1) * kstep; \
            const char* a2 = last ? nA : cA + (size_t)(t + 2) * kstep; const char* b2 = last ? nB : cB + (size_t)(t + 2) * kstep; \
            const char* a3 = a2 + kstep; const char* b3 = b2 + kstep; \
            PG8_LDB(B0, 0, 0); PG8_LDB(B1, 0, 1); PG8_SCHED; PG8_LDA(At, 0, 0); PG8_STAGE(PG8_SA(1, 1), a1 + hstep, voffA); \
            PG8_WAIT_V(8); PG8_WAIT_L(0); PG8_BAR; PG8_MMA(0, 0, At, B0); PG8_MMA(0, 1, At, B1); PG8_BAR; PG8_SCHED; \
            PG8_LDA(At, 0, 1); PG8_STAGE(PG8_SB(0, 0), b2, voffB); PG8_STAGE(PG8_SB(0, 1), b2 + hstep, voffB); PG8_STAGE(PG8_SA(0, 0), a2, voffA); \
            PG8_WAIT_V(8); PG8_WAIT_L(0); PG8_BAR; PG8_MMA(1, 0, At, B0); PG8_MMA(1, 1, At, B1); PG8_BAR; PG8_SCHED; \
            PG8_LDB(B0, 1, 0); PG8_LDB(B1, 1, 1); PG8_SCHED; PG8_LDA(At, 1, 0); PG8_STAGE(PG8_SA(0, 1), a2 + hstep, voffA); \
            PG8_WAIT_V(8); PG8_WAIT_L(0); PG8_BAR; PG8_MMA(0, 0, At, B0); PG8_MMA(0, 1, At, B1); PG8_BAR; PG8_SCHED; \
            PG8_LDA(At, 1, 1); PG8_STAGE(PG8_SB(1, 0), b3, voffB); PG8_STAGE(PG8_SB(1, 1), b3 + hstep, voffB); PG8_STAGE(PG8_SA(1, 0), a3, voffA); \
            PG8_WAIT_V(8); PG8_WAIT_L(0); PG8_BAR; PG8_MMA(1, 0, At, B0); PG8_MMA(1, 1, At, B1); PG8_BAR; PG8_SCHED; \
        } while (0)
    Unit cur, nxt; int ui = 0;
    if (!S.next(0, cur)) return;
    f32x4 acc[2][2][4][2];
#pragma unroll
    for (int a = 0; a < 2; ++a)
#pragma unroll
        for (int b = 0; b < 2; ++b)
#pragma unroll
            for (int m = 0; m < 4; ++m)
#pragma unroll
                for (int n = 0; n < 2; ++n) acc[a][b][m][n] = (f32x4){0.f, 0.f, 0.f, 0.f};
    bf16x8 At[4][2], B0[2][2], B1[2][2];
    const char* cA = (const char*)g.A + (size_t)cur.pm * tstep; const char* cB = (const char*)g.Bt + (size_t)cur.pn * tstep;
    PG8_STAGE(PG8_SB(0, 0), cB, voffB); PG8_STAGE(PG8_SB(0, 1), cB + hstep, voffB); PG8_STAGE(PG8_SA(0, 0), cA, voffA); PG8_STAGE(PG8_SA(0, 1), cA + hstep, voffA);
    if (wr == 1) PG8_BAR;
    PG8_WAIT_V(2); PG8_BAR;
    PG8_STAGE(PG8_SB(1, 0), cB + kstep, voffB); PG8_STAGE(PG8_SA(1, 0), cA + kstep, voffA); PG8_STAGE(PG8_SB(1, 1), cB + hstep + kstep, voffB);
    PG8_WAIT_V(6); PG8_BAR;
    for (;;) {
        const bool has_next = S.next(ui + 1, nxt);
        const char* nA = has_next ? (const char*)g.A + (size_t)nxt.pm * tstep : cA; const char* nB = has_next ? (const char*)g.Bt + (size_t)nxt.pn * tstep : cB;
        if constexpr (Epi::MIDHOOK) {
            for (int t = 0; t < nt / 2; t += 2) PG8_KBODY(t);
            E.mid(acc, cur, wr, wc, fr, fq);
            for (int t = nt / 2; t < nt; t += 2) PG8_KBODY(t);
        } else {
            for (int t = 0; t < nt; t += 2) PG8_KBODY(t);
        }
        if (wr == 0) PG8_BAR;
        if constexpr (Epi::FUSED) E.fused(acc, cur, wr, wc, fr, fq, lds + 131072, wid, lane); else { if (KDUP == 1 || !Epi::DUPSKIP || (ui % KDUP) == KDUP - 1) E(acc, cur, wr, wc, fr, fq); }
        if (!has_next) break;
#pragma unroll
        for (int a = 0; a < 2; ++a)
#pragma unroll
            for (int b = 0; b < 2; ++b)
#pragma unroll
                for (int m = 0; m < 4; ++m)
#pragma unroll
                    for (int n = 0; n < 2; ++n) acc[a][b][m][n] = (f32x4){0.f, 0.f, 0.f, 0.f};
        cur = nxt; cA = nA; cB = nB; ++ui;
        if (wr == 1) PG8_BAR;
    }
    PG8_WAIT_V(0);
    PG8_BAR;
#undef PG8_KBODY
#undef PG8_SA
#undef PG8_SB
#undef PG8_STAGE
#undef PG8_LDA
#undef PG8_LDB
#undef PG8_MMA
#undef PG8_WAIT_V
#undef PG8_WAIT_L
#undef PG8_BAR
#undef PG8_SCHED
}
}

__device__ __forceinline__ void st_out(u32x4* p, u32x4 w, bool keep) { if (keep) *p = w; else __builtin_nontemporal_store(w, p); }
struct EpiP1 {
    static constexpr bool PERM = true, MIDHOOK = false, FUSED = false, DUPSKIP = true;
    bf16_t *YAB, *VA, *KB, *VB, *ZB, *GA, *GB; float* ssv; LAS float* pss;
    template <int ACT> __device__ __forceinline__ void plain(const f32x4 (&acc)[2][2][4][2], bf16_t* base, int ldc, int row0, int colt, int slot, int fq, bool keep) const {
        const float qs = 0.08838834764831845f * LOG2E;
#pragma unroll
        for (int ai = 0; ai < 2; ++ai)
#pragma unroll
            for (int m = 0; m < 4; ++m) {
                const int row = row0 + ai * 128 + m * 16; float ss = 0.f;
#pragma unroll
                for (int bj = 0; bj < 2; ++bj) {
                    float o[8];
#pragma unroll
                    for (int n = 0; n < 2; ++n)
#pragma unroll
                        for (int j = 0; j < 4; ++j) { float v = acc[ai][bj][m][n][j];
                            if (ACT == 1) { v = gelu_tanh(v); ss += v * v; } else if (ACT == 2) v *= qs; else if (ACT == 3) v = v * rcpf_(1.f + ex2(-v * LOG2E));
                            o[n * 4 + j] = v; }
                    u32x4 w; w.x = pk_bf16(o[0], o[1]); w.y = pk_bf16(o[2], o[3]); w.z = pk_bf16(o[4], o[5]); w.w = pk_bf16(o[6], o[7]);
                    st_out((u32x4*)(base + (size_t)row * ldc + colt + bj * 128), w, keep);
                }
                if (ACT == 1) { ss = xsum_fq(ss); if (fq == 0) pss[((row & 255) << 2) + (slot & 3)] = ss; }
            }
        if (ACT == 1) {
            asm volatile("s_waitcnt lgkmcnt(0)" ::: "memory"); __builtin_amdgcn_s_barrier(); asm volatile("" ::: "memory");
            const int tid = threadIdx.x;
            if (tid < 256) { const f32x4 p = *((const LAS f32x4*)pss + tid); *(f32x4*)(ssv + (size_t)((row0 & ~255) + tid) * 16 + (slot & ~3)) = p; }
        }
    }
    __device__ __forceinline__ void operator()(const f32x4 (&acc)[2][2][4][2], const pg8::Unit& u, int wr, int wc, int fr, int fq) const {
        const int pn = u.pn; const int row0 = u.pm * 256 + wr * 64 + fr; const int cw = wc * 32 + 8 * fq;
        const bool keep = (u.pm & 31) >= 24;
        if (pn < 8) {
            const int col = pn * 128 + cw;
#pragma unroll
            for (int ai = 0; ai < 2; ++ai)
#pragma unroll
                for (int m = 0; m < 4; ++m) {
                    float o[8];
#pragma unroll
                    for (int n = 0; n < 2; ++n)
#pragma unroll
                        for (int j = 0; j < 4; ++j) { const float uu = acc[ai][0][m][n][j], zz = acc[ai][1][m][n][j]; o[n * 4 + j] = (uu * zz) * rcpf_((1.f + gelu_e(uu)) * (1.f + ex2(-zz * LOG2E))); }
                    u32x4 w; w.x = pk_bf16(o[0], o[1]); w.y = pk_bf16(o[2], o[3]); w.z = pk_bf16(o[4], o[5]); w.w = pk_bf16(o[6], o[7]);
                    st_out((u32x4*)(YAB + (size_t)(row0 + ai * 128 + m * 16) * 2048 + col), w, keep);
                }
        } else if (pn < 28) {
            const int seg = (pn - 8) >> 2; const int colt = ((pn - 8) & 3) * 256 + cw;
            if (seg == 0) plain<1>(acc, VA, 1024, row0, colt, (pn - 8) * 4 + wc, fq, keep);
            else if (seg == 1) plain<2>(acc, YAB + 1024, 2048, row0, colt, 0, fq, keep);
            else if (seg == 2) plain<0>(acc, KB, 1024, row0, colt, 0, fq, keep);
            else if (seg == 3) plain<0>(acc, VB, 1024, row0, colt, 0, fq, keep);
            else plain<3>(acc, ZB, 1024, row0, colt, 0, fq, keep);
        } else {
            const int col = (pn - 28) * 128 + cw;
#pragma unroll
            for (int ai = 0; ai < 2; ++ai)
#pragma unroll
                for (int m = 0; m < 4; ++m) {
                    float oa[8], ob[8];
#pragma unroll
                    for (int n = 0; n < 2; ++n)
#pragma unroll
                        for (int j = 0; j < 4; ++j) { const float ea = ex2(fminf(-acc[ai][0][m][n][j] * LOG2E, 60.f)), eb = ex2(fminf(-acc[ai][1][m][n][j] * LOG2E, 60.f));
                            oa[n * 4 + j] = (1.f + eb) * rcpf_(1.f + ea); ob[n * 4 + j] = rcpf_(1.f + eb); }
                    u32x4 w; w.x = pk_bf16(oa[0], oa[1]); w.y = pk_bf16(oa[2], oa[3]); w.z = pk_bf16(oa[4], oa[5]); w.w = pk_bf16(oa[6], oa[7]);
                    u32x4 x; x.x = pk_bf16(ob[0], ob[1]); x.y = pk_bf16(ob[2], ob[3]); x.z = pk_bf16(ob[4], ob[5]); x.w = pk_bf16(ob[6], ob[7]);
                    const size_t off = (size_t)(row0 + ai * 128 + m * 16) * 1024 + col;
                    __builtin_nontemporal_store(w, (u32x4*)(GA + off)); __builtin_nontemporal_store(x, (u32x4*)(GB + off));
                }
        }
    }
};
struct EpiP3 {
    static constexpr bool PERM = true, MIDHOOK = true, FUSED = false, DUPSKIP = false;
    const bf16_t *GA, *GB; bf16_t* MG;
    __device__ __forceinline__ void mid(f32x4 (&acc)[2][2][4][2], const pg8::Unit& u, int wr, int wc, int fr, int fq) const {
        const int row0 = u.pm * 256 + wr * 64 + fr; const int col0 = u.pn * 256 + wc * 32 + 8 * fq;
        unsigned base_off = (unsigned)row0 * 1024u + (unsigned)col0; asm volatile("" : "+v"(base_off));
#pragma unroll
        for (int ai = 0; ai < 2; ++ai) {
            u32x4 a[4][2];
#pragma unroll
            for (int m = 0; m < 4; ++m)
#pragma unroll
                for (int bj = 0; bj < 2; ++bj) a[m][bj] = *(const u32x4*)(GA + base_off + (unsigned)((ai * 128 + m * 16) * 1024 + bj * 128));
#pragma unroll
            for (int m = 0; m < 4; ++m)
#pragma unroll
                for (int bj = 0; bj < 2; ++bj) { const u32x4 r = a[m][bj];
                    acc[ai][bj][m][0] *= (f32x4){bf_lo(r.x), bf_hi(r.x), bf_lo(r.y), bf_hi(r.y)}; acc[ai][bj][m][1] *= (f32x4){bf_lo(r.z), bf_hi(r.z), bf_lo(r.w), bf_hi(r.w)}; }
            asm volatile("" : "+v"(acc[ai][0][0][0]), "+v"(acc[ai][0][0][1]), "+v"(acc[ai][1][0][0]), "+v"(acc[ai][1][0][1]), "+v"(acc[ai][0][1][0]), "+v"(acc[ai][0][1][1]), "+v"(acc[ai][1][1][0]), "+v"(acc[ai][1][1][1]),
                              "+v"(acc[ai][0][2][0]), "+v"(acc[ai][0][2][1]), "+v"(acc[ai][1][2][0]), "+v"(acc[ai][1][2][1]), "+v"(acc[ai][0][3][0]), "+v"(acc[ai][0][3][1]), "+v"(acc[ai][1][3][0]), "+v"(acc[ai][1][3][1]) :: "memory");
        }
    }
    __device__ __forceinline__ void operator()(const f32x4 (&acc)[2][2][4][2], const pg8::Unit& u, int wr, int wc, int fr, int fq) const {
        const int row0 = u.pm * 256 + wr * 64 + fr; const int col0 = u.pn * 256 + wc * 32 + 8 * fq;
        const bf16_t* GB2 = GB; asm volatile("" : "+s"(GB2));
        unsigned base_off = (unsigned)row0 * 1024u + (unsigned)col0; asm volatile("" : "+v"(base_off));
        u32x4 b[2][4][2];
#pragma unroll
        for (int ai = 0; ai < 2; ++ai)
#pragma unroll
            for (int m = 0; m < 4; ++m)
#pragma unroll
                for (int bj = 0; bj < 2; ++bj) b[ai][m][bj] = *(const u32x4*)(GB2 + base_off + (unsigned)((ai * 128 + m * 16) * 1024 + bj * 128));
#pragma unroll
        for (int ai = 0; ai < 2; ++ai)
#pragma unroll
            for (int m = 0; m < 4; ++m)
#pragma unroll
                for (int bj = 0; bj < 2; ++bj) {
                    const unsigned off = base_off + (unsigned)((ai * 128 + m * 16) * 1024 + bj * 128);
                    const u32x4 gb = b[ai][m][bj];
                    const f32x4 v0 = acc[ai][bj][m][0], v1 = acc[ai][bj][m][1];
                    u32x4 w; w.x = pk_bf16(v0[0] * bf_lo(gb.x), v0[1] * bf_hi(gb.x)); w.y = pk_bf16(v0[2] * bf_lo(gb.y), v0[3] * bf_hi(gb.y));
                    w.z = pk_bf16(v1[0] * bf_lo(gb.z), v1[1] * bf_hi(gb.z)); w.w = pk_bf16(v1[2] * bf_lo(gb.w), v1[3] * bf_hi(gb.w));
                    __builtin_nontemporal_store(w, (u32x4*)(MG + off));
                }
        asm volatile("" ::: "memory");
    }
};
struct EpiP4 {
    static constexpr bool PERM = false, MIDHOOK = false, FUSED = true, DUPSKIP = false;
    const float* x; float* out; const float* gain; float* slots; unsigned* cnt;
    __device__ __forceinline__ void fused(f32x4 (&acc)[2][2][4][2], const pg8::Unit& u, int wr, int wc, int fr, int fq, LAS unsigned char* ldsm, int wid, int lane) const {
        LAS float* P = (LAS float*)(ldsm + 1024);
        LAS float* S = (LAS float*)(ldsm + 1024 + 4096);
        const int row0 = u.pm * 256 + wr * 64 + fr; const int col0 = u.pn * 256 + wc * 32 + 4 * fq;
#pragma unroll
        for (int ai = 0; ai < 2; ++ai)
#pragma unroll
            for (int m = 0; m < 4; ++m) {
                const int row = row0 + ai * 128 + m * 16; float ss = 0.f;
#pragma unroll
                for (int bj = 0; bj < 2; ++bj)
#pragma unroll
                    for (int n = 0; n < 2; ++n) {
                        const f32x4 v = *(const f32x4*)(x + (size_t)row * 1024 + col0 + bj * 128 + n * 16) + acc[ai][bj][m][n];
                        ss += (v[0] * v[0] + v[1] * v[1]) + (v[2] * v[2] + v[3] * v[3]);
                        acc[ai][bj][m][n] = v;
                    }
                ss = xsum_fq(ss);
                if (fq == 0) P[(ai * 128 + wr * 64 + m * 16 + fr) * 4 + wc] = ss;
                if (m & 1) asm volatile("" : "+v"(acc[ai][0][m][0]), "+v"(acc[ai][0][m][1]), "+v"(acc[ai][1][m][0]), "+v"(acc[ai][1][m][1]), "+v"(acc[ai][0][m - 1][0]), "+v"(acc[ai][0][m - 1][1]), "+v"(acc[ai][1][m - 1][0]), "+v"(acc[ai][1][m - 1][1]) :: "memory");
            }
        asm volatile("s_waitcnt lgkmcnt(0)" ::: "memory"); __builtin_amdgcn_s_barrier(); asm volatile("" ::: "memory");
        const int tid = wid * 64 + lane;
        unsigned* pc = cnt + 64 * u.pm;
        if (tid < 256) {
            const f32x4 p = *(const LAS f32x4*)(P + tid * 4);
            const float tot = (p[0] + p[1]) + (p[2] + p[3]);
            __hip_atomic_store(slots + ((size_t)(u.pm * 256 + tid) * 4 + u.pn), tot, __ATOMIC_RELAXED, __HIP_MEMORY_SCOPE_AGENT);
            asm volatile("s_waitcnt vmcnt(0)" ::: "memory");
            if (lane == 0) __hip_atomic_fetch_add(pc, 1u, __ATOMIC_RELAXED, __HIP_MEMORY_SCOPE_AGENT);
        }
        if (wid == 0) {
            unsigned spins = 0;
            while ((unsigned)__builtin_amdgcn_readfirstlane(__hip_atomic_load(pc, __ATOMIC_RELAXED, __HIP_MEMORY_SCOPE_AGENT)) < 16u) { __builtin_amdgcn_s_sleep(2); if (++spins > (1u << 24)) break; }
            __builtin_amdgcn_fence(__ATOMIC_ACQUIRE, "agent");
        }
        asm volatile("s_waitcnt vmcnt(0) lgkmcnt(0)" ::: "memory"); __builtin_amdgcn_s_barrier(); asm volatile("" ::: "memory");
        if (tid < 256) {
            const float* sl = slots + (size_t)(u.pm * 256 + tid) * 4;
            const float a0 = __hip_atomic_load(sl + 0, __ATOMIC_RELAXED, __HIP_MEMORY_SCOPE_AGENT), a1 = __hip_atomic_load(sl + 1, __ATOMIC_RELAXED, __HIP_MEMORY_SCOPE_AGENT);
            const float a2 = __hip_atomic_load(sl + 2, __ATOMIC_RELAXED, __HIP_MEMORY_SCOPE_AGENT), a3 = __hip_atomic_load(sl + 3, __ATOMIC_RELAXED, __HIP_MEMORY_SCOPE_AGENT);
            S[tid] = 1.0f / sqrtf(((a0 + a1) + (a2 + a3)) * (1.0f / 1024.0f) + EPS);
        }
        asm volatile("s_waitcnt vmcnt(0) lgkmcnt(0)" ::: "memory"); __builtin_amdgcn_s_barrier(); asm volatile("" ::: "memory");
        f32x4 gn[2][2];
#pragma unroll
        for (int bj = 0; bj < 2; ++bj)
#pragma unroll
            for (int n = 0; n < 2; ++n) gn[bj][n] = *(const f32x4*)(gain + col0 + bj * 128 + n * 16);
#pragma unroll
        for (int ai = 0; ai < 2; ++ai)
#pragma unroll
            for (int m = 0; m < 4; ++m) {
                const int rl = ai * 128 + wr * 64 + m * 16 + fr; const float r = S[rl]; const size_t ro = (size_t)(u.pm * 256 + rl) * 1024 + col0;
#pragma unroll
                for (int bj = 0; bj < 2; ++bj)
#pragma unroll
                    for (int n = 0; n < 2; ++n) __builtin_nontemporal_store(acc[ai][bj][m][n] * r * gn[bj][n], (f32x4*)(out + ro + bj * 128 + n * 16));
            }
    }
};

__device__ __forceinline__ void transpose_item(const float* W, int N, bf16_t* WT, int ldk, int kofs, int dst_row0, LAS float* scr, int k0, int n0, int lane) {
#pragma unroll 8
    for (int i = 0; i < 32; ++i) { const int kk = 2 * i + (lane >> 5); scr[kk * 33 + (lane & 31)] = W[(size_t)(k0 + kk) * N + n0 + (lane & 31)]; }
    asm volatile("s_waitcnt lgkmcnt(0)" ::: "memory");
    const int c = lane & 7;
#pragma unroll
    for (int j = 0; j < 4; ++j) { const int n = (lane >> 3) + 8 * j; const LAS float* s = scr + (8 * c) * 33 + n;
        u32x4 o; o.x = pk_bf16(s[0 * 33], s[1 * 33]); o.y = pk_bf16(s[2 * 33], s[3 * 33]); o.z = pk_bf16(s[4 * 33], s[5 * 33]); o.w = pk_bf16(s[6 * 33], s[7 * 33]);
        *(u32x4*)(WT + (size_t)(dst_row0 + n) * ldk + kofs + k0 + 8 * c) = o; }
    asm volatile("s_waitcnt lgkmcnt(0)" ::: "memory");
}
__device__ __forceinline__ int win_dst_row(int n0) {
    const int seg = n0 >> 10, within = n0 & 1023, j = within >> 7, i = within & 127;
    if (seg == 0) return 256 * j + i;
    if (seg == 2) return 256 * j + 128 + i;
    if (seg == 1) return 2048 + within;
    if (seg <= 6) return seg * 1024 + within;
    if (seg == 7) return 7168 + 256 * j + i;
    return 7168 + 256 * j + 128 + i;
}

constexpr int ATT_KBUF = 16384, ATT_VBUF = 20480, ATT_K0 = 0, ATT_V0 = 2 * ATT_KBUF, ATT_FLAGS = ATT_V0 + 2 * ATT_VBUF;
#ifndef SB_EARLY_EXIT
#define SB_EARLY_EXIT 1
#endif
__device__ __forceinline__ s16x4 tr16(const LAS unsigned char* p) { return __builtin_bit_cast(s16x4, __builtin_amdgcn_ds_read_tr16_b64_v4i16((LAS s16x4*)p)); }

__device__ __forceinline__ void att_tile(const LAS unsigned char* Kb, const LAS unsigned char* Vb, int t, int qw0, int myq, int hi, int kperm, unsigned vlane,
                                         const bf16x8 (&qf)[8], f32x16 (&o)[4], float& carry, bool walive) {
#pragma unroll
        for (int sbi = 0; sbi < 2; ++sbi) {
            const int sb = 1 - sbi; const int kb = 64 * t + 32 * sb;
            if (kb < qw0 + 31 && walive) {
                const int krow = 32 * sb + kperm; const int swz = (krow & 7) + 8 * ((krow >> 4) & 1);
                const LAS unsigned char* kp = Kb + krow * 256;
                f32x16 s;
#pragma unroll
                for (int r = 0; r < 16; ++r) s[r] = 0.f;
#pragma unroll
                for (int kk = 0; kk < 8; ++kk) { const bf16x8 a = *(const LAS bf16x8*)(kp + (((2 * kk + hi) ^ swz) * 16)); s = __builtin_amdgcn_mfma_f32_32x32x16_bf16(a, qf[kk], s, 0, 0, 0); }
                const bool needmask = (kb + 31 >= qw0);
                const int key0 = kb + 16 * hi;
                float wl[16]; float Ploc = 1.f;
                if (needmask) {
#pragma unroll
                    for (int r = 15; r >= 0; --r) {
                        float beta = rcpf_(1.f + ex2(-s[r]));
                        if (key0 + r >= myq) beta = 0.f;
                        wl[r] = beta * Ploc; Ploc -= wl[r];
                    }
                } else {
#pragma unroll
                    for (int r = 15; r >= 0; --r) { wl[r] = Ploc * rcpf_(1.f + ex2(-s[r])); Ploc -= wl[r]; }
                }
                const float Tother = __shfl_xor(Ploc, 32);
                const float cstart = carry * (hi == 0 ? Tother : 1.f);
                carry = carry * (Ploc * Tother);
                u32x4 w0, w1;
                w0.x = pk_bf16(wl[0] * cstart, wl[1] * cstart); w0.y = pk_bf16(wl[2] * cstart, wl[3] * cstart); w0.z = pk_bf16(wl[4] * cstart, wl[5] * cstart); w0.w = pk_bf16(wl[6] * cstart, wl[7] * cstart);
                w1.x = pk_bf16(wl[8] * cstart, wl[9] * cstart); w1.y = pk_bf16(wl[10] * cstart, wl[11] * cstart); w1.z = pk_bf16(wl[12] * cstart, wl[13] * cstart); w1.w = pk_bf16(wl[14] * cstart, wl[15] * cstart);
                const bf16x8 wb0 = __builtin_bit_cast(bf16x8, w0), wb1 = __builtin_bit_cast(bf16x8, w1);
                const LAS unsigned char* vp = Vb + (32 * sb) * 320 + vlane;
#pragma unroll
                for (int dt = 0; dt < 4; ++dt) {
                    const s16x4 a0 = tr16(vp + dt * 64), a1 = tr16(vp + 4 * 320 + dt * 64);
                    const s16x4 c0 = tr16(vp + 8 * 320 + dt * 64), c1 = tr16(vp + 12 * 320 + dt * 64);
                    const bf16x8 fa = __builtin_shufflevector(a0, a1, 0, 1, 2, 3, 4, 5, 6, 7), fc = __builtin_shufflevector(c0, c1, 0, 1, 2, 3, 4, 5, 6, 7);
                    o[dt] = __builtin_amdgcn_mfma_f32_32x32x16_bf16(fa, wb0, o[dt], 0, 0, 0);
                    o[dt] = __builtin_amdgcn_mfma_f32_32x32x16_bf16(fc, wb1, o[dt], 0, 0, 0);
                }
            }
        }
}

__device__ __forceinline__ void attn_unit(LAS unsigned char* lds, int b, int h, int qt, bf16_t* YAB, const bf16_t* KB, const bf16_t* VB, const bf16_t* ZB, bool do_store) {
    const int tid = threadIdx.x, lane = tid & 63, wid = __builtin_amdgcn_readfirstlane(tid >> 6), r32 = lane & 31, hi = lane >> 5;
    const int tok0 = b * SEQ, q0 = qt * 256, qw0 = q0 + 32 * wid, myq = qw0 + r32;
    bf16x8 qf[8];
    { const bf16_t* qp = YAB + (size_t)(tok0 + myq) * 2048 + 1024 + h * HD + 8 * hi;
#pragma unroll
      for (int kk = 0; kk < 8; ++kk) qf[kk] = *(const bf16x8*)(qp + 16 * kk); }
    const int skey0 = tid >> 4, sc0 = tid & 15; const int sswz = (skey0 & 7) + 8 * ((skey0 >> 4) & 1);
    const unsigned kdst0 = (unsigned)(skey0 * 256 + ((sc0 ^ sswz) * 16)), vdst0 = (unsigned)(skey0 * 320 + sc0 * 16);
    const bf16_t* kg = KB + (size_t)tok0 * 1024 + h * HD; const bf16_t* vg = VB + (size_t)tok0 * 1024 + h * HD;
    u32x4 kA[2], vA[2], kB[2], vB[2];
    const int T0 = qt * 4 + 3;
#define ATT_LOAD(KR, VR, tile) do { _Pragma("unroll") for (int i = 0; i < 2; ++i) { const size_t go = (size_t)(64 * (tile) + skey0 + 32 * i) * 1024 + 8 * sc0; KR[i] = *(const u32x4*)(kg + go); VR[i] = *(const u32x4*)(vg + go); } } while (0)
#define ATT_WRITE(KR, VR, buf) do { _Pragma("unroll") for (int i = 0; i < 2; ++i) { *(LAS u32x4*)(lds + ATT_K0 + (buf) * ATT_KBUF + kdst0 + 8192 * i) = KR[i]; *(LAS u32x4*)(lds + ATT_V0 + (buf) * ATT_VBUF + vdst0 + 10240 * i) = VR[i]; } } while (0)
    ATT_LOAD(kA, vA, T0); ATT_LOAD(kB, vB, T0 - 1);
    ATT_WRITE(kA, vA, 0);
    __syncthreads();
    f32x16 o[4];
#pragma unroll
    for (int d = 0; d < 4; ++d)
#pragma unroll
        for (int r = 0; r < 16; ++r) o[d][r] = 0.f;
    float carry = 1.f; bool walive = true;
    const int kperm = 16 * ((r32 >> 2) & 1) + (r32 & 3) + 4 * (r32 >> 3);
    const int i16 = lane & 15, qd = i16 >> 2, pp = i16 & 3, blk = (lane >> 4) & 1;
    const unsigned vlane = (unsigned)((16 * hi + qd) * 320 + (16 * blk + 4 * pp) * 2);
    int cur = 0; int it = 0; int t = T0;
#define ATT_STEP(KF, VF, KH, VH) { \
        if (t >= 2) ATT_LOAD(KF, VF, t - 2); \
        att_tile(lds + ATT_K0 + cur * ATT_KBUF, lds + ATT_V0 + cur * ATT_VBUF, t, qw0, myq, hi, kperm, vlane, qf, o, carry, walive); \
        if (t >= 1) ATT_WRITE(KH, VH, cur ^ 1); \
        walive = __any(carry > 0x1p-134f);     \
        if (lane == 0) ((LAS unsigned*)(lds + ATT_FLAGS))[(it & 1) * 8 + wid] = walive ? 1u : 0u; \
        __syncthreads(); \
        { const LAS unsigned* fl = (const LAS unsigned*)(lds + ATT_FLAGS) + (it & 1) * 8; \
          const unsigned any = fl[0] | fl[1] | fl[2] | fl[3] | fl[4] | fl[5] | fl[6] | fl[7]; \
          if (any == 0u || t == 0) break; }     \
        --t; cur ^= 1; ++it; }
    for (;;) {
        ATT_STEP(kA, vA, kB, vB)
        ATT_STEP(kB, vB, kA, vA)
    }
#undef ATT_STEP
#undef ATT_LOAD
#undef ATT_WRITE
    { const bf16_t* zp = ZB + (size_t)(tok0 + myq) * 1024 + h * HD + 8 * hi; bf16_t* op = YAB + (size_t)(tok0 + myq) * 2048 + 1024 + h * HD + 8 * hi;
#pragma unroll
      for (int dt = 0; dt < 4; ++dt)
#pragma unroll
          for (int p = 0; p < 2; ++p) {
              const u32x4 z = *(const u32x4*)(zp + 32 * dt + 16 * p);
              float v[8];
#pragma unroll
              for (int j = 0; j < 4; ++j) {
                  const auto rr = __builtin_amdgcn_permlane32_swap(__float_as_uint(o[dt][8 * p + j]), __float_as_uint(o[dt][8 * p + 4 + j]), false, false);
                  v[j] = __uint_as_float(rr[0]); v[4 + j] = __uint_as_float(rr[1]);
              }
              u32x4 w; w.x = pk_bf16(v[0] * bf_lo(z.x), v[1] * bf_hi(z.x)); w.y = pk_bf16(v[2] * bf_lo(z.y), v[3] * bf_hi(z.y));
              w.z = pk_bf16(v[4] * bf_lo(z.z), v[5] * bf_hi(z.z)); w.w = pk_bf16(v[6] * bf_lo(z.w), v[7] * bf_hi(z.w));
              if (do_store) *(u32x4*)(op + 32 * dt + 16 * p) = w;
          } }
}

constexpr int GM_V = 0, GM_RSTD = 40960, GM_STG = 41472, GM_STGP = 132;
__device__ __forceinline__ void gmlp_phase(LAS unsigned char* lds, int cu, int G, bf16_t* YAB, const bf16_t* VA, const float* ssv, const float* w_s, const float* b_s, const float* norm_v, const int pass) {
    const int tid = threadIdx.x, lane = tid & 63, wid = __builtin_amdgcn_readfirstlane(tid >> 6), r32 = lane & 31, hi = lane >> 5;
    const int ttile = wid & 3, chalf = wid >> 2; const int t = 32 * ttile + r32;
    const bool fixg = (G & 7) == 0;
    const int nun = fixg ? (512 - (cu >> 3) + (G >> 3) - 1) / (G >> 3) : (4096 - cu + G - 1) / G;
    if (nun <= 0) return;
#define GM_UNIT(i, p_, g_) do { if (fixg && G == 256) { const int s_ = cu >> 3; p_ = 16 * (2 * (i) + ((s_ >> 4) ^ (((i) >> 1) & 1))) + (s_ & 15); g_ = cu & 7; } \
        else if (fixg) { p_ = (cu >> 3) + (G >> 3) * (i); g_ = cu & 7; } else { const int v_ = cu + G * (i); p_ = v_ >> 3; g_ = v_ & 7; } } while (0)
    u32x4 vld[4], uzC[4]; f32x4 ssl[4];
    f32x4 wa[8], wb[8], bs[4]; float nv[2]; int gcur = -1;
#define GM_LOADS(p_, g_) do { const int tok_ = ((p_) >> 4) * SEQ + ((p_) & 15) * CHUNK; \
        _Pragma("unroll") for (int i = 0; i < 4; ++i) { const int id = tid + 512 * i, s_ = id >> 4, c_ = id & 15; \
            vld[i] = *(const u32x4*)(VA + (size_t)(tok_ + s_) * 1024 + (g_) * 128 + 8 * c_); } \
        if (tid < 128) { const f32x4* p4 = (const f32x4*)(ssv + (size_t)(tok_ + tid) * 16); ssl[0] = p4[0]; ssl[1] = p4[1]; ssl[2] = p4[2]; ssl[3] = p4[3]; } } while (0)
#define GM_NEXT(from, out) do { out = -1; for (int i_ = (from); i_ < nun; ++i_) { int pp_, gg_; GM_UNIT(i_, pp_, gg_); if (((((pp_) >> 4) & 3) == 3) == (pass == 0)) { out = i_; break; } } } while (0)
    int icur; GM_NEXT(0, icur);
    if (icur < 0) return;
    int p, g; GM_UNIT(icur, p, g);
    GM_LOADS(p, g);
    const int i16 = lane & 15, qd = i16 >> 2, pp = i16 & 3, blk = (lane >> 4) & 1;
    const LAS unsigned char* vp = lds + GM_V + (8 * hi + qd) * 320 + (64 * chalf + 16 * blk + 4 * pp) * 2;
    const LAS float* rs = (const LAS float*)(lds + GM_RSTD);
    const int nks = 2 * (ttile + 1);
    while (icur >= 0) {
        int inext; GM_NEXT(icur + 1, inext);
        const int tok0 = (p >> 4) * SEQ + (p & 15) * CHUNK;
        if (g != gcur) {
            const float* wrow = w_s + ((size_t)g * 128 + t) * 128 + 8 * hi;
#pragma unroll
            for (int kk = 0; kk < 8; ++kk) { wa[kk] = *(const f32x4*)(wrow + 16 * kk); wb[kk] = *(const f32x4*)(wrow + 16 * kk + 4); }
#pragma unroll
            for (int ct = 0; ct < 2; ++ct) nv[ct] = norm_v[g * 128 + 64 * chalf + 32 * ct + r32];
#pragma unroll
            for (int g4 = 0; g4 < 4; ++g4) bs[g4] = *(const f32x4*)(b_s + g * 128 + 32 * ttile + 8 * g4 + 4 * hi);
            gcur = g;
        }
#pragma unroll
        for (int i = 0; i < 4; ++i) { const int id = tid + 512 * i, s_ = id >> 4, c_ = id & 15; *(LAS u32x4*)(lds + GM_V + s_ * 320 + c_ * 16) = vld[i]; }
        if (tid < 128) {
            const float sum = ((ssl[0][0] + ssl[0][1]) + (ssl[0][2] + ssl[0][3])) + ((ssl[1][0] + ssl[1][1]) + (ssl[1][2] + ssl[1][3])) + ((ssl[2][0] + ssl[2][1]) + (ssl[2][2] + ssl[2][3])) + ((ssl[3][0] + ssl[3][1]) + (ssl[3][2] + ssl[3][3]));
            ((LAS float*)(lds + GM_RSTD))[tid] = 1.0f / sqrtf(sum * (1.0f / 1024.0f) + EPS); }
        __syncthreads();
        int pn_ = p, gn_ = g;
#pragma unroll
        for (int i = 0; i < 4; ++i) { const int id = tid + 512 * i, s_ = id >> 4, c_ = id & 15; uzC[i] = *(const u32x4*)(YAB + (size_t)(tok0 + s_) * 2048 + g * 128 + 8 * c_); }
        if (inext >= 0) { GM_UNIT(inext, pn_, gn_); GM_LOADS(pn_, gn_); }
        f32x16 acc[2];
#pragma unroll
        for (int ct = 0; ct < 2; ++ct)
#pragma unroll
            for (int r = 0; r < 16; ++r) acc[ct][r] = 0.f;
#pragma unroll
        for (int kk = 0; kk < 8; ++kk) {
            if (kk < nks) {
                const int s0 = 16 * kk + 8 * hi;
                const f32x4 ra = *(const LAS f32x4*)(rs + s0), rb = *(const LAS f32x4*)(rs + s0 + 4);
                float a8[8];
#pragma unroll
                for (int j = 0; j < 4; ++j) { a8[j] = (s0 + j <= t) ? wa[kk][j] * ra[j] : 0.f; a8[4 + j] = (s0 + 4 + j <= t) ? wb[kk][j] * rb[j] : 0.f; }
                u32x4 aw; aw.x = pk_bf16(a8[0], a8[1]); aw.y = pk_bf16(a8[2], a8[3]); aw.z = pk_bf16(a8[4], a8[5]); aw.w = pk_bf16(a8[6], a8[7]);
                const bf16x8 af = __builtin_bit_cast(bf16x8, aw);
#pragma unroll
                for (int ct = 0; ct < 2; ++ct) {
                    const s16x4 lo = tr16(vp + (16 * kk) * 320 + ct * 64), hi4 = tr16(vp + (16 * kk + 4) * 320 + ct * 64);
                    const bf16x8 bfr = __builtin_shufflevector(lo, hi4, 0, 1, 2, 3, 4, 5, 6, 7);
                    acc[ct] = __builtin_amdgcn_mfma_f32_32x32x16_bf16(af, bfr, acc[ct], 0, 0, 0);
                }
            }
        }
        { LAS float* stg = (LAS float*)(lds + GM_STG);
#pragma unroll
          for (int ct = 0; ct < 2; ++ct) { const int c = 64 * chalf + 32 * ct + r32;
#pragma unroll
              for (int g4 = 0; g4 < 4; ++g4) { const int tb = 32 * ttile + 8 * g4 + 4 * hi;
#pragma unroll
                  for (int j = 0; j < 4; ++j) stg[(tb + j) * GM_STGP + c] = acc[ct][4 * g4 + j] * nv[ct] + bs[g4][j]; } } }
        __syncthreads();
#pragma unroll
        for (int i = 0; i < 4; ++i) { const int id = tid + 512 * i, tt = id >> 4, cc = id & 15;
            const LAS float* sp = (const LAS float*)(lds + GM_STG) + tt * GM_STGP + 8 * cc; const f32x4 m0 = *(const LAS f32x4*)sp, m1 = *(const LAS f32x4*)(sp + 4);
            bf16_t* gp = YAB + (size_t)(tok0 + tt) * 2048 + g * 128 + 8 * cc; const u32x4 uz = uzC[i];
            u32x4 w; w.x = pk_bf16(bf_lo(uz.x) * m0[0], bf_hi(uz.x) * m0[1]); w.y = pk_bf16(bf_lo(uz.y) * m0[2], bf_hi(uz.y) * m0[3]);
            w.z = pk_bf16(bf_lo(uz.z) * m1[0], bf_hi(uz.z) * m1[1]); w.w = pk_bf16(bf_lo(uz.w) * m1[2], bf_hi(uz.w) * m1[3]);
            *(u32x4*)gp = w; }
        __syncthreads();
        p = pn_; g = gn_; icur = inext;
    }
#undef GM_NEXT
#undef GM_UNIT
#undef GM_LOADS
}


#define XB_TMO      128
#define XB_XCNT(j)  (256  + 64 * (j))
#define XB_XSUB(j)  (1280 + 64 * (j))
#define XB_XGEN(j)  (2304 + 64 * (j))
#define XB_TOP      3328
#define XB_TOPGEN   3392
#define XCD_BAR_WORDS 3456
#define XB_SPIN_CAP (1u << 18)
__device__ __forceinline__ unsigned xb_ld(unsigned* p)              { return __hip_atomic_load(p, __ATOMIC_RELAXED, __HIP_MEMORY_SCOPE_AGENT); }
__device__ __forceinline__ unsigned xb_add(unsigned* p, unsigned v) { return __hip_atomic_fetch_add(p, v, __ATOMIC_RELAXED, __HIP_MEMORY_SCOPE_AGENT); }
__device__ __forceinline__ unsigned xb_xcc_id() { return (unsigned)__builtin_amdgcn_s_getreg((3 << 11) | 20) & 0xFu; }
#define XB_SPIN(cond, bar) do { unsigned _sp = 0; while (cond) { __builtin_amdgcn_s_sleep(1); \
    if ((++_sp & 255u) == 0u) { if (xb_ld(&(bar)[XB_TMO])) break; if (_sp > XB_SPIN_CAP) { atomicAdd(&(bar)[XB_TMO], 1u); break; } } } } while (0)
struct XcdBarrier { unsigned* bar; unsigned x; volatile LAS unsigned* st; };
__device__ __forceinline__ XcdBarrier xcd_barrier_post(unsigned* bar, volatile LAS unsigned* st) {
    XcdBarrier b; b.bar = bar; b.x = xb_xcc_id(); b.st = st;
    if (threadIdx.x == 0) (void)xb_add(&bar[XB_XCNT(b.x)], 1u);
    return b;
}
__device__ __forceinline__ void xcd_barrier_complete(unsigned* bar, unsigned x, unsigned& nloc, unsigned& nx) {
    const unsigned G = gridDim.x * gridDim.y * gridDim.z;
    unsigned sum, cnt, mine, sp = 0u;
    for (;;) {
        sum = 0u; cnt = 0u; mine = 0u;
#pragma unroll
        for (unsigned j = 0; j < 16; ++j) { const unsigned c = xb_ld(&bar[XB_XCNT(j)]); sum += c; cnt += (c > 0u) ? 1u : 0u; mine = (j == x) ? c : mine; }
        if (sum == G) break;
        __builtin_amdgcn_s_sleep(1);
        if ((++sp & 255u) == 0u) { if (xb_ld(&bar[XB_TMO])) break; if (sp > XB_SPIN_CAP) { atomicAdd(&bar[XB_TMO], 1u); break; } }
    }
    nloc = mine > 0u ? mine : 1u; nx = cnt > 0u ? cnt : 1u;
}
__device__ __forceinline__ void xcd_barrier(unsigned* bar_, volatile LAS unsigned* st_) {
    asm volatile("s_waitcnt vmcnt(0)" ::: "memory");
    __syncthreads();
    if (threadIdx.x == 0) {
        XcdBarrier b; b.bar = bar_; b.x = xb_xcc_id(); b.st = st_;
        unsigned* bar = b.bar;
        __builtin_amdgcn_s_waitcnt(0);
        unsigned nloc = b.st[0], nx = b.st[1];
        if (nloc == 0u) { xcd_barrier_complete(bar, b.x, nloc, nx); b.st[0] = nloc; b.st[1] = nx; }
        const unsigned old = xb_add(&bar[XB_XSUB(b.x)], 1u);
        const unsigned gen = old / nloc;
        if (old + 1u == (gen + 1u) * nloc) {
            __builtin_amdgcn_fence(__ATOMIC_RELEASE, "agent");
            asm volatile("s_waitcnt vmcnt(0)" ::: "memory");
            const unsigned og = xb_add(&bar[XB_TOP], 1u);
            const unsigned tg = og / nx;
            if (og + 1u == (tg + 1u) * nx) xb_add(&bar[XB_TOPGEN], 1u);
            else XB_SPIN(xb_ld(&bar[XB_TOPGEN]) == tg, bar);
            __builtin_amdgcn_fence(__ATOMIC_ACQUIRE, "agent");
            xb_add(&bar[XB_XGEN(b.x)], 1u);
            asm volatile("s_waitcnt vmcnt(0)" ::: "memory");
        } else {
            XB_SPIN(xb_ld(&bar[XB_XGEN(b.x)]) == gen, bar);
            __builtin_amdgcn_fence(__ATOMIC_ACQUIRE, "agent");
            asm volatile("s_waitcnt vmcnt(0)" ::: "memory");
        }
    }
    __syncthreads();
}

struct Args { const float* in[10]; float* out; unsigned char* ws; };
#ifndef PHM
#define PHM 31
#endif
#ifndef ATT_REP
#define ATT_REP 1
#endif
#ifndef GM_REP
#define GM_REP 1
#endif
#ifndef REP0
#define REP0 1
#endif
#ifndef REP1
#define REP1 1
#endif
#ifndef REP3
#define REP3 1
#endif
#ifndef REP4
#define REP4 1
#endif
#ifndef P2M
#define P2M 3
#endif
constexpr int N_ATT = BATCH * NH * (SEQ / 256), N_GM = BATCH * (SEQ / CHUNK) * NG;

__global__ void __launch_bounds__(512, 2) fwd_megakernel(Args args) {
    extern __shared__ __attribute__((aligned(16))) unsigned char lds_raw[];
    LAS unsigned char* lds = (LAS unsigned char*)lds_raw;
    cg::grid_group grid = cg::this_grid();
    const int tid = threadIdx.x, lane = tid & 63, wave = __builtin_amdgcn_readfirstlane(tid >> 6);
    const int G = gridDim.x;
    const float* x = args.in[0]; const float* norm_in = args.in[1]; const float* w_in = args.in[2]; const float* norm_v = args.in[3]; const float* w_s = args.in[4];
    const float* b_s = args.in[5]; const float* w_o_gmlp = args.in[6]; const float* w_o_sb = args.in[7]; const float* w_out = args.in[8]; const float* norm_final = args.in[9];
    unsigned char* ws = args.ws; float* out = args.out;
    unsigned* ctl = (unsigned*)(ws + WS_CTL);
    volatile LAS unsigned* xst = (volatile LAS unsigned*)(lds + LDS_MISC + 64);
    if (tid < 2) xst[tid] = 0u;
    __syncthreads();
    for (unsigned w = blockIdx.x * 512u + tid; w < CTL_BYTES / 4; w += gridDim.x * 512u) ctl[w] = 0u;
    bf16_t* WIN = (bf16_t*)(ws + WS_WIN); bf16_t* WCAT = (bf16_t*)(ws + WS_WCAT); bf16_t* WOUT = (bf16_t*)(ws + WS_WOUT);
    float* ssv = (float*)(ws + WS_SSV); float* ssf = (float*)(ws + WS_SSF);
    bf16_t* YAB = (bf16_t*)(ws + WS_YAB); bf16_t* VA = (bf16_t*)(ws + WS_VA); bf16_t* VB = (bf16_t*)(ws + WS_VB); bf16_t* ZB = (bf16_t*)(ws + WS_ZB);
    bf16_t* GA = (bf16_t*)(ws + WS_GA); bf16_t* GB = (bf16_t*)(ws + WS_GB); bf16_t* MG = VA;
    bf16_t* XN = (bf16_t*)out; bf16_t* KB = (bf16_t*)out + (size_t)M * 1024;

    for (int rep_ = 0; rep_ < REP0; ++rep_) {
        LAS float* scr = (LAS float*)(lds + wave * 16384);
        const int gw = blockIdx.x * 8 + wave, NGW = G * 8;
        constexpr int I_IN = 16 * (NIN / 32), I_SQ = 16 * 32;
        for (int it = gw; it < I_IN + 3 * I_SQ; it += NGW) {
            int r = it;
            if (r < I_IN) { const int kb = r / (NIN / 32), nb = r % (NIN / 32); transpose_item(w_in, NIN, WIN, 1024, 0, win_dst_row(32 * nb), scr, 64 * kb, 32 * nb, lane); continue; }
            r -= I_IN; const int which = r / I_SQ; r -= which * I_SQ; const int kb = r / 32, nb = r % 32;
            if (which == 0) transpose_item(w_o_gmlp, 1024, WCAT, 2048, 0, 32 * nb, scr, 64 * kb, 32 * nb, lane);
            else if (which == 1) transpose_item(w_o_sb, 1024, WCAT, 2048, 1024, 32 * nb, scr, 64 * kb, 32 * nb, lane);
            else transpose_item(w_out, 1024, WOUT, 1024, 0, 32 * nb, scr, 64 * kb, 32 * nb, lane);
        }
        f32x4 gn[4];
#pragma unroll
        for (int j = 0; j < 4; ++j) gn[j] = *((const f32x4*)norm_in + lane + 64 * j);
        for (int m = gw; m < M; m += 4 * NGW) {
            f32x4 v[4][4]; float sq[4];
#pragma unroll
            for (int q = 0; q < 4; ++q) { const int mq = (m + q * NGW < M) ? m + q * NGW : m; const f32x4* xr = (const f32x4*)(x + (size_t)mq * DM) + lane;
#pragma unroll
                for (int j = 0; j < 4; ++j) v[q][j] = xr[64 * j]; }
#pragma unroll
            for (int q = 0; q < 4; ++q) { float a = 0.f;
#pragma unroll
                for (int j = 0; j < 4; ++j) a += (v[q][j][0] * v[q][j][0] + v[q][j][1] * v[q][j][1]) + (v[q][j][2] * v[q][j][2] + v[q][j][3] * v[q][j][3]);
                sq[q] = a; }
#pragma unroll
            for (int o = 1; o < 64; o <<= 1) {
#pragma unroll
                for (int q = 0; q < 4; ++q) sq[q] += __shfl_xor(sq[q], o); }
#pragma unroll
            for (int q = 0; q < 4; ++q) if (m + q * NGW < M) {
                const float r = 1.0f / sqrtf(sq[q] * (1.0f / DM) + EPS);
                u32x2* o8 = (u32x2*)(XN + (size_t)(m + q * NGW) * DM) + lane;
#pragma unroll
                for (int j = 0; j < 4; ++j) { u32x2 w; w.x = pk_bf16(v[q][j][0] * r * gn[j][0], v[q][j][1] * r * gn[j][1]); w.y = pk_bf16(v[q][j][2] * r * gn[j][2], v[q][j][3] * r * gn[j][3]); o8[64 * j] = w; }
            }
        }
    }
    grid.sync();
    (void)xcd_barrier_post(ctl + 20480, xst);

    {
        pg8::Gemm g{XN, WIN, M, NIN, DM}; pg8::StaticOrder S; S.init(M, NIN, G, (int)blockIdx.x, REP1, KDUP);
        EpiP1 E{YAB, VA, KB, VB, ZB, GA, GB, ssv, (LAS float*)(lds + LDS_MISC + 1024)};
        pg8::gemm_phase<EpiP1, pg8::StaticOrder>(lds, g, S, E);
    }
    xcd_barrier((unsigned*)((unsigned char*)args.ws + WS_CTL) + 20480, (volatile LAS unsigned*)(lds + LDS_MISC + 64));

    if (PHM & 4) {
        gmlp_phase(lds, (int)blockIdx.x, G, YAB, VA, ssv, w_s, b_s, norm_v, 0);
        __syncthreads();
        LAS int* uw = (LAS int*)(lds + LDS_MISC);
        if (tid == 0) uw[0] = (int)atomicAdd(ctl + 0, 1u);
        __syncthreads();
        int u = uw[0];
        for (int k = 0; u < N_ATT; ++k) {
            int unext = 0;
            if (tid == 0) unext = (int)atomicAdd(ctl + 0, 1u);
            {
                const int cls = 3 - (u >> 9), r = u & 511; const int qt = 7 - (r >> 6), j = r & 63; const int b = 4 * (j >> 3) + cls, h = j & 7;
                attn_unit(lds, b, h, qt, YAB, KB, VB, ZB, true); }
            if (tid == 0) uw[(k + 1) & 1] = unext;
            __syncthreads();
            u = uw[(k + 1) & 1];
        }
        __syncthreads();
        gmlp_phase(lds, (int)blockIdx.x, G, YAB, VA, ssv, w_s, b_s, norm_v, 1);
    }
    xcd_barrier((unsigned*)((unsigned char*)args.ws + WS_CTL) + 20480, (volatile LAS unsigned*)(lds + LDS_MISC + 64));

    {
        pg8::Gemm g{YAB, WCAT, M, DM, 2048}; pg8::StaticOrder S; S.init(M, DM, G, (int)blockIdx.x, REP3);
        EpiP3 E{GA, GB, MG};
        pg8::gemm_phase<EpiP3, pg8::StaticOrder>(lds, g, S, E);
    }
    xcd_barrier((unsigned*)((unsigned char*)args.ws + WS_CTL) + 20480, (volatile LAS unsigned*)(lds + LDS_MISC + 64));

    {
        pg8::Gemm g{MG, WOUT, M, DM, DM}; pg8::StaticOrder S; S.init(M, DM, G, (int)blockIdx.x, REP4);
        EpiP4 E{x, out, norm_final, ssf, ctl + 1024};
        pg8::gemm_phase<EpiP4, pg8::StaticOrder>(lds, g, S, E);
    }
}

extern "C" void kernel_launch(void* const* d_in, const int* in_sizes, int n_in, void* d_out, int out_size, void* d_ws, size_t ws_size, hipStream_t stream) {
    static int grid_blocks = 0;
    if (grid_blocks == 0) {
        if (n_in != 10 || in_sizes[0] != M * DM || out_size != M * DM || ws_size < WS_END) { fprintf(stderr, "kernel_launch: unexpected shapes / workspace (%d inputs, ws %zu)\n", n_in, ws_size); grid_blocks = -1; return; }
        int dev = 0, cus = 0, per_cu = 0;
        hipGetDevice(&dev); hipDeviceGetAttribute(&cus, hipDeviceAttributeMultiprocessorCount, dev);
        hipFuncSetAttribute((const void*)fwd_megakernel, hipFuncAttributeMaxDynamicSharedMemorySize, LDS_BYTES);
        hipOccupancyMaxActiveBlocksPerMultiprocessor(&per_cu, (const void*)fwd_megakernel, 512, LDS_BYTES);
        if (per_cu < 1) per_cu = 1;
        grid_blocks = cus * per_cu;
        (void)hipGetLastError();
    }
    if (grid_blocks < 0) return;
    Args a{};
    for (int i = 0; i < 10; ++i) a.in[i] = (const float*)d_in[i];
    a.out = (float*)d_out; a.ws = (unsigned char*)d_ws;
    void* kargs[] = {&a};
    hipError_t e = hipLaunchCooperativeKernel((const void*)fwd_megakernel, dim3(grid_blocks), dim3(512), kargs, LDS_BYTES, stream);
    if (e != hipSuccess) fprintf(stderr, "cooperative launch failed: %s (grid %d)\n", hipGetErrorString(e), grid_blocks);
}
```

```cpp
#include <hip/hip_runtime.h>
#include <hip/hip_cooperative_groups.h>
#include <cstdio>
#include <cstdint>
namespace cg = cooperative_groups;

#define LAS __attribute__((address_space(3)))
#define GAS __attribute__((address_space(1)))
typedef unsigned short bf16_t;
typedef short bf16x8 __attribute__((ext_vector_type(8)));
typedef short s16x4 __attribute__((ext_vector_type(4)));
typedef float f32x4 __attribute__((ext_vector_type(4)));
typedef float f32x2 __attribute__((ext_vector_type(2)));
typedef float f32x16 __attribute__((ext_vector_type(16)));
typedef unsigned u32x4 __attribute__((ext_vector_type(4)));
typedef unsigned u32x2 __attribute__((ext_vector_type(2)));
typedef __bf16 bf16x2_t __attribute__((ext_vector_type(2)));

constexpr int DM = 1024, BATCH = 32, SEQ = 2048, M = BATCH * SEQ;
constexpr int NIN = 9216, NH = 8, HD = 128, CHUNK = 128, NG = 8;
constexpr float EPS = 1e-6f;
constexpr float LOG2E = 1.4426950408889634f;

constexpr size_t MiB = 1u << 20;
constexpr size_t WS_CTL = 0, CTL_BYTES = 131072;
constexpr size_t WS_WIN = 2 * MiB, WS_WCAT = 20 * MiB, WS_WOUT = 24 * MiB, WS_SSV = 26 * MiB, WS_SSF = 30 * MiB;
constexpr size_t WS_YAB = 64 * MiB, WS_VA = 320 * MiB, WS_VB = 448 * MiB, WS_ZB = 576 * MiB, WS_GA = 704 * MiB, WS_GB = 832 * MiB, WS_END = 960 * MiB;
constexpr int LDS_RING = 131072, LDS_MISC = 131072, LDS_BYTES = 147456;

__device__ __forceinline__ float ex2(float x) { return __builtin_amdgcn_exp2f(x); }
__device__ __forceinline__ float rcpf_(float x) { return __builtin_amdgcn_rcpf(x); }
__device__ __forceinline__ unsigned pk_bf16(float lo, float hi) { f32x2 v = {lo, hi}; bf16x2_t b = __builtin_convertvector(v, bf16x2_t); return __builtin_bit_cast(unsigned, b); }
__device__ __forceinline__ float bf_lo(unsigned w) { return __uint_as_float(w << 16); }
__device__ __forceinline__ float bf_hi(unsigned w) { return __uint_as_float(w & 0xffff0000u); }
__device__ __forceinline__ float sigmoidf_(float x) { return rcpf_(1.f + ex2(-x * LOG2E)); }
constexpr float GC0 = -1.5957691216057308f * LOG2E, GC1 = -1.5957691216057308f * 0.044715f * LOG2E;
__device__ __forceinline__ float gelu_e(float x) { return ex2(x * (GC0 + GC1 * (x * x))); }
__device__ __forceinline__ float gelu_tanh(float x) { return x * rcpf_(1.f + gelu_e(x)); }
__device__ __forceinline__ float siluf_(float x) { return x * sigmoidf_(x); }
__device__ __forceinline__ float xsum_fq(float v) {
    const auto a = __builtin_amdgcn_permlane16_swap(__float_as_uint(v), __float_as_uint(v), false, false);
    const float t = __uint_as_float(a[0]) + __uint_as_float(a[1]);
    const auto b = __builtin_amdgcn_permlane32_swap(__float_as_uint(t), __float_as_uint(t), false, false);
    return __uint_as_float(b[0]) + __uint_as_float(b[1]);
}
__device__ __forceinline__ float wave_sum(float v) {
#pragma unroll
    for (int o = 1; o < 64; o <<= 1) v += __shfl_xor(v, o);
    return v;
}

#ifndef KDUP
#define KDUP 1
#endif
namespace pg8 {
constexpr int BM = 256, BK = 64, HALF = 128, HTB = HALF * BK * 2, STAGE_BYTES = 8 * HTB, NXCD = 8, WGM = 8;
__host__ __device__ __forceinline__ int lds_byte(int r, int c) { const int st = (r >> 4) * 2 + (c >> 5), rr = r & 15, cc = c & 31, ob = rr * 64 + cc * 2; return st * 1024 + (ob ^ (((ob >> 9) & 1) << 5)); }
__host__ __device__ __forceinline__ void stage_rc(int b, int& R, int& C) { const int st = b / 1024, sb = b % 1024, swz = sb ^ (((sb >> 9) & 1) << 5); R = (st >> 1) * 16 + swz / 64; C = (st & 1) * 32 + (swz % 64) / 2; }
__host__ __device__ __forceinline__ int perm32(int rho) { const int n = rho >> 4, i = rho & 15; return 8 * (i >> 2) + 4 * n + (i & 3); }
struct Unit { int pm, pn; };
struct Gemm { const bf16_t* A; const bf16_t* Bt; int M, N, K; };
struct StaticOrder {
    int nM, nN, nwg, G, c, rep, dup;
    __device__ void init(int M_, int N_, int G_, int c_, int rep_ = 1, int dup_ = 1) { nM = M_ / BM; nN = N_ / BM; nwg = nM * nN; G = G_; c = c_; rep = rep_; dup = dup_; }
    __device__ bool next(int i, Unit& u) const {
        long L = (long)(i / dup) * G + c; if (L >= (long)nwg * rep) return false; L %= nwg;
        int wgid = (int)L; { const int q = nwg / NXCD, r = nwg % NXCD, xcd = wgid % NXCD, off = wgid / NXCD; wgid = (xcd < r ? xcd * (q + 1) : r * (q + 1) + (xcd - r) * q) + off; }
        const int nig = WGM * nN, gid = wgid / nig, fm = gid * WGM, gsz = (nM - fm) < WGM ? (nM - fm) : WGM;
        u.pm = fm + ((wgid % nig) % gsz); u.pn = (wgid % nig) / gsz; return true;
    }
};
struct PanelOrder {
    int nM, nN, G, c, rep;
    __device__ void init(int M_, int N_, int G_, int c_, int rep_ = 1) { nM = M_ / BM; nN = N_ / BM; G = G_; c = c_; rep = rep_; }
    __device__ bool next(int i, Unit& u) const { const int pm = c + G * (i / (nN * rep)); if (pm >= nM) return false; u.pm = pm; u.pn = i % nN; return true; }
};

template <class Epi, class Sched>
__device__ __forceinline__ void gemm_phase(LAS unsigned char* lds, const Gemm g, const Sched& S, const Epi& E) {
    const int tid = threadIdx.x, wid = __builtin_amdgcn_readfirstlane(tid >> 6), lane = tid & 63, wr = wid >> 2, wc = wid & 3, fr = lane & 15, fq = lane >> 4;
    const int K = g.K, nt = K / BK;
    unsigned voffA[2], voffB[2];
#pragma unroll
    for (int i = 0; i < 2; ++i) { int R, C; stage_rc(tid * 16 + i * 8192, R, C); const int Rb = Epi::PERM ? ((R & ~31) + perm32(R & 31)) : R;
        voffA[i] = (unsigned)(R * K + C) * 2u; voffB[i] = (unsigned)(Rb * K + C) * 2u; }
    const size_t kstep = (size_t)(BK * 2);
    const size_t hstep = (size_t)HALF * K * 2;
    const size_t tstep = 2 * hstep;
    const unsigned ldsw = (unsigned)wid * 1024u;
    const int aoff = lds_byte(wr * 64 + fr, fq * 8), boff = lds_byte(wc * 32 + fr, fq * 8);
#define PG8_SA(b, h) (((b) * 2 + (h)) * HTB)
#define PG8_SB(b, h) ((4 + (b) * 2 + (h)) * HTB)
#define PG8_STAGE(bufoff, gbase, voff) do { _Pragma("unroll") for (int _i = 0; _i < 2; ++_i) \
        __builtin_amdgcn_global_load_lds((const unsigned*)((const char*)(gbase) + (voff)[_i]), (LAS unsigned*)(lds + (bufoff) + ldsw + _i * 8192), 16, 0, 0); } while (0)
#define PG8_LDA(dst, b, h) do { _Pragma("unroll") for (int m = 0; m < 4; ++m) _Pragma("unroll") for (int k = 0; k < 2; ++k) dst[m][k] = *(const LAS bf16x8*)(lds + PG8_SA(b, h) + aoff + m * 2048 + k * 1024); } while (0)
#define PG8_LDB(dst, b, h) do { _Pragma("unroll") for (int n = 0; n < 2; ++n) _Pragma("unroll") for (int k = 0; k < 2; ++k) dst[n][k] = *(const LAS bf16x8*)(lds + PG8_SB(b, h) + boff + n * 2048 + k * 1024); } while (0)
#define PG8_MMA(ai, bj, At, Bt) do { __builtin_amdgcn_s_setprio(1); _Pragma("unroll") for (int m = 0; m < 4; ++m) _Pragma("unroll") for (int n = 0; n < 2; ++n) _Pragma("unroll") for (int k = 0; k < 2; ++k) \
        acc[ai][bj][m][n] = __builtin_amdgcn_mfma_f32_16x16x32_bf16(Bt[n][k], At[m][k], acc[ai][bj][m][n], 0, 0, 0); __builtin_amdgcn_s_setprio(0); } while (0)
#define PG8_WAIT_V(n) asm volatile("s_waitcnt vmcnt(" #n ")" ::: "memory")
#define PG8_WAIT_L(n) asm volatile("s_waitcnt lgkmcnt(" #n ")" ::: "memory")
#define PG8_BAR __builtin_amdgcn_s_barrier()
#define PG8_SCHED __builtin_amdgcn_sched_barrier(0)
#define PG8_KBODY(t) do { \
            const bool last = (t == nt - 2); \
            const char* a1 = cA + (size_t)(t + 1) * kstep; \
            const char* a2 = last ? nA : cA + (size_t)(t + 2) * kstep; const char* b2 = last ? nB : cB + (size_t)(t + 2) * kstep; \
            const char* a3 = a2 + kstep; const char* b3 = b2 + kstep; \
            PG8_LDB(B0, 0, 0); PG8_LDB(B1, 0, 1); PG8_SCHED; PG8_LDA(At, 0, 0); PG8_STAGE(PG8_SA(1, 1), a1 + hstep, voffA); \
            PG8_WAIT_V(8); PG8_WAIT_L(0); PG8_BAR; PG8_MMA(0, 0, At, B0); PG8_MMA(0, 1, At, B1); PG8_BAR; PG8_SCHED; \
            PG8_LDA(At, 0, 1); PG8_STAGE(PG8_SB(0, 0), b2, voffB); PG8_STAGE(PG8_SB(0, 1), b2 + hstep, voffB); PG8_STAGE(PG8_SA(0, 0), a2, voffA); \
            PG8_WAIT_V(8); PG8_WAIT_L(0); PG8_BAR; PG8_MMA(1, 0, At, B0); PG8_MMA(1, 1, At, B1); PG8_BAR; PG8_SCHED; \
            PG8_LDB(B0, 1, 0); PG8_LDB(B1, 1, 1); PG8_SCHED; PG8_LDA(At, 1, 0); PG8_STAGE(PG8_SA(0, 1), a2 + hstep, voffA); \
            PG8_WAIT_V(8); PG8_WAIT_L(0); PG8_BAR; PG8_MMA(0, 0, At, B0); PG8_MMA(0, 1, At, B1); PG8_BAR; PG8_SCHED; \
            PG8_LDA(At, 1, 1); PG8_STAGE(PG8_SB(1, 0), b3, voffB); PG8_STAGE(PG8_SB(1, 1), b3 + hstep, voffB); PG8_STAGE(PG8_SA(1, 0), a3, voffA); \
            PG8_WAIT_V(8); PG8_WAIT_L(0); PG8_BAR; PG8_MMA(1, 0, At, B0); PG8_MMA(1, 1, At, B1); PG8_BAR; PG8_SCHED; \
        } while (0)
    Unit cur, nxt; int ui = 0;
    if (!S.next(0, cur)) return;
    f32x4 acc[2][2][4][2];
#pragma unroll
    for (int a = 0; a < 2; ++a)
#pragma unroll
        for (int b = 0; b < 2; ++b)
#pragma unroll
            for (int m = 0; m < 4; ++m)
#pragma unroll
                for (int n = 0; n < 2; ++n) acc[a][b][m][n] = (f32x4){0.f, 0.f, 0.f, 0.f};
    bf16x8 At[4][2], B0[2][2], B1[2][2];
    const char* cA = (const char*)g.A + (size_t)cur.pm * tstep; const char* cB = (const char*)g.Bt + (size_t)cur.pn * tstep;
    PG8_STAGE(PG8_SB(0, 0), cB, voffB); PG8_STAGE(PG8_SB(0, 1), cB + hstep, voffB); PG8_STAGE(PG8_SA(0, 0), cA, voffA); PG8_STAGE(PG8_SA(0, 1), cA + hstep, voffA);
    if (wr == 1) PG8_BAR;
    PG8_WAIT_V(2); PG8_BAR;
    PG8_STAGE(PG8_SB(1, 0), cB + kstep, voffB); PG8_STAGE(PG8_SA(1, 0), cA + kstep, voffA); PG8_STAGE(PG8_SB(1, 1), cB + hstep + kstep, voffB);
    PG8_WAIT_V(6); PG8_BAR;
    for (;;) {
        const bool has_next = S.next(ui + 1, nxt);
        const char* nA = has_next ? (const char*)g.A + (size_t)nxt.pm * tstep : cA; const char* nB = has_next ? (const char*)g.Bt + (size_t)nxt.pn * tstep : cB;
        if constexpr (Epi::MIDHOOK) {
            for (int t = 0; t < nt / 2; t += 2) PG8_KBODY(t);
            E.mid(acc, cur, wr, wc, fr, fq);
            for (int t = nt / 2; t < nt; t += 2) PG8_KBODY(t);
        } else {
            for (int t = 0; t < nt; t += 2) PG8_KBODY(t);
        }
        if (wr == 0) PG8_BAR;
        if constexpr (Epi::FUSED) E.fused(acc, cur, wr, wc, fr, fq, lds + 131072, wid, lane); else { if (KDUP == 1 || !Epi::DUPSKIP || (ui % KDUP) == KDUP - 1) E(acc, cur, wr, wc, fr, fq); }
        if (!has_next) break;
#pragma unroll
        for (int a = 0; a < 2; ++a)
#pragma unroll
            for (int b = 0; b < 2; ++b)
#pragma unroll
                for (int m = 0; m < 4; ++m)
#pragma unroll
                    for (int n = 0; n < 2; ++n) acc[a][b][m][n] = (f32x4){0.f, 0.f, 0.f, 0.f};
        cur = nxt; cA = nA; cB = nB; ++ui;
        if (wr == 1) PG8_BAR;
    }
    PG8_WAIT_V(0);
    PG8_BAR;
#undef PG8_KBODY
#undef PG8_SA
#undef PG8_SB
#undef PG8_STAGE
#undef PG8_LDA
#undef PG8_LDB
#undef PG8_MMA
#undef PG8_WAIT_V
#undef PG8_WAIT_L
#undef PG8_BAR
#undef PG8_SCHED
}
}

__device__ __forceinline__ void st_out(u32x4* p, u32x4 w, bool keep) { if (keep) *p = w; else __builtin_nontemporal_store(w, p); }
struct EpiP1 {
    static constexpr bool PERM = true, MIDHOOK = false, FUSED = false, DUPSKIP = true;
    bf16_t *YAB, *VA, *KB, *VB, *ZB, *GA, *GB; float* ssv; LAS float* pss;
    template <int ACT> __device__ __forceinline__ void plain(const f32x4 (&acc)[2][2][4][2], bf16_t* base, int ldc, int row0, int colt, int slot, int fq, bool keep) const {
        const float qs = 0.08838834764831845f * LOG2E;
#pragma unroll
        for (int ai = 0; ai < 2; ++ai)
#pragma unroll
            for (int m = 0; m < 4; ++m) {
                const int row = row0 + ai * 128 + m * 16; float ss = 0.f;
#pragma unroll
                for (int bj = 0; bj < 2; ++bj) {
                    float o[8];
#pragma unroll
                    for (int n = 0; n < 2; ++n)
#pragma unroll
                        for (int j = 0; j < 4; ++j) { float v = acc[ai][bj][m][n][j];
                            if (ACT == 1) { v = gelu_tanh(v); ss += v * v; } else if (ACT == 2) v *= qs; else if (ACT == 3) v = v * rcpf_(1.f + ex2(-v * LOG2E));
                            o[n * 4 + j] = v; }
                    u32x4 w; w.x = pk_bf16(o[0], o[1]); w.y = pk_bf16(o[2], o[3]); w.z = pk_bf16(o[4], o[5]); w.w = pk_bf16(o[6], o[7]);
                    st_out((u32x4*)(base + (size_t)row * ldc + colt + bj * 128), w, keep);
                }
                if (ACT == 1) { ss = xsum_fq(ss); if (fq == 0) pss[((row & 255) << 2) + (slot & 3)] = ss; }
            }
        if (ACT == 1) {
            asm volatile("s_waitcnt lgkmcnt(0)" ::: "memory"); __builtin_amdgcn_s_barrier(); asm volatile("" ::: "memory");
            const int tid = threadIdx.x;
            if (tid < 256) { const f32x4 p = *((const LAS f32x4*)pss + tid); *(f32x4*)(ssv + (size_t)((row0 & ~255) + tid) * 16 + (slot & ~3)) = p; }
        }
    }
    __device__ __forceinline__ void operator()(const f32x4 (&acc)[2][2][4][2], const pg8::Unit& u, int wr, int wc, int fr, int fq) const {
        const int pn = u.pn; const int row0 = u.pm * 256 + wr * 64 + fr; const int cw = wc * 32 + 8 * fq;
        const bool keep = (u.pm & 31) >= 24;
        const bool keepkv = (u.pm & 31) >= 16;
        if (pn < 8) {
            const int col = pn * 128 + cw;
#pragma unroll
            for (int ai = 0; ai < 2; ++ai)
#pragma unroll
                for (int m = 0; m < 4; ++m) {
                    float o[8];
#pragma unroll
                    for (int n = 0; n < 2; ++n)
#pragma unroll
                        for (int j = 0; j < 4; ++j) { const float uu = acc[ai][0][m][n][j], zz = acc[ai][1][m][n][j]; o[n * 4 + j] = (uu * zz) * rcpf_((1.f + gelu_e(uu)) * (1.f + ex2(-zz * LOG2E))); }
                    u32x4 w; w.x = pk_bf16(o[0], o[1]); w.y = pk_bf16(o[2], o[3]); w.z = pk_bf16(o[4], o[5]); w.w = pk_bf16(o[6], o[7]);
                    st_out((u32x4*)(YAB + (size_t)(row0 + ai * 128 + m * 16) * 2048 + col), w, keep);
                }
        } else if (pn < 28) {
            const int seg = (pn - 8) >> 2; const int colt = ((pn - 8) & 3) * 256 + cw;
            if (seg == 0) plain<1>(acc, VA, 1024, row0, colt, (pn - 8) * 4 + wc, fq, keep);
            else if (seg == 1) plain<2>(acc, YAB + 1024, 2048, row0, colt, 0, fq, keep);
            else if (seg == 2) plain<0>(acc, KB, 1024, row0, colt, 0, fq, keepkv);
            else if (seg == 3) plain<0>(acc, VB, 1024, row0, colt, 0, fq, keepkv);
            else plain<3>(acc, ZB, 1024, row0, colt, 0, fq, keep);
        } else {
            const int col = (pn - 28) * 128 + cw;
#pragma unroll
            for (int ai = 0; ai < 2; ++ai)
#pragma unroll
                for (int m = 0; m < 4; ++m) {
                    float oa[8], ob[8];
#pragma unroll
                    for (int n = 0; n < 2; ++n)
#pragma unroll
                        for (int j = 0; j < 4; ++j) { const float ea = ex2(fminf(-acc[ai][0][m][n][j] * LOG2E, 60.f)), eb = ex2(fminf(-acc[ai][1][m][n][j] * LOG2E, 60.f));
                            oa[n * 4 + j] = (1.f + eb) * rcpf_(1.f + ea); ob[n * 4 + j] = rcpf_(1.f + eb); }
                    u32x4 w; w.x = pk_bf16(oa[0], oa[1]); w.y = pk_bf16(oa[2], oa[3]); w.z = pk_bf16(oa[4], oa[5]); w.w = pk_bf16(oa[6], oa[7]);
                    u32x4 x; x.x = pk_bf16(ob[0], ob[1]); x.y = pk_bf16(ob[2], ob[3]); x.z = pk_bf16(ob[4], ob[5]); x.w = pk_bf16(ob[6], ob[7]);
                    const size_t off = (size_t)(row0 + ai * 128 + m * 16) * 1024 + col;
                    __builtin_nontemporal_store(w, (u32x4*)(GA + off)); __builtin_nontemporal_store(x, (u32x4*)(GB + off));
                }
        }
    }
};
struct EpiP3 {
    static constexpr bool PERM = true, MIDHOOK = true, FUSED = false, DUPSKIP = false;
    const bf16_t *GA, *GB; bf16_t* MG;
    __device__ __forceinline__ void mid(f32x4 (&acc)[2][2][4][2], const pg8::Unit& u, int wr, int wc, int fr, int fq) const {
        const int row0 = u.pm * 256 + wr * 64 + fr; const int col0 = u.pn * 256 + wc * 32 + 8 * fq;
        unsigned base_off = (unsigned)row0 * 1024u + (unsigned)col0; asm volatile("" : "+v"(base_off));
#pragma unroll
        for (int ai = 0; ai < 2; ++ai) {
            u32x4 a[4][2];
#pragma unroll
            for (int m = 0; m < 4; ++m)
#pragma unroll
                for (int bj = 0; bj < 2; ++bj) a[m][bj] = *(const u32x4*)(GA + base_off + (unsigned)((ai * 128 + m * 16) * 1024 + bj * 128));
#pragma unroll
            for (int m = 0; m < 4; ++m)
#pragma unroll
                for (int bj = 0; bj < 2; ++bj) { const u32x4 r = a[m][bj];
                    acc[ai][bj][m][0] *= (f32x4){bf_lo(r.x), bf_hi(r.x), bf_lo(r.y), bf_hi(r.y)}; acc[ai][bj][m][1] *= (f32x4){bf_lo(r.z), bf_hi(r.z), bf_lo(r.w), bf_hi(r.w)}; }
            asm volatile("" : "+v"(acc[ai][0][0][0]), "+v"(acc[ai][0][0][1]), "+v"(acc[ai][1][0][0]), "+v"(acc[ai][1][0][1]), "+v"(acc[ai][0][1][0]), "+v"(acc[ai][0][1][1]), "+v"(acc[ai][1][1][0]), "+v"(acc[ai][1][1][1]),
                              "+v"(acc[ai][0][2][0]), "+v"(acc[ai][0][2][1]), "+v"(acc[ai][1][2][0]), "+v"(acc[ai][1][2][1]), "+v"(acc[ai][0][3][0]), "+v"(acc[ai][0][3][1]), "+v"(acc[ai][1][3][0]), "+v"(acc[ai][1][3][1]) :: "memory");
        }
    }
    __device__ __forceinline__ void operator()(const f32x4 (&acc)[2][2][4][2], const pg8::Unit& u, int wr, int wc, int fr, int fq) const {
        const int row0 = u.pm * 256 + wr * 64 + fr; const int col0 = u.pn * 256 + wc * 32 + 8 * fq;
        const bf16_t* GB2 = GB; asm volatile("" : "+s"(GB2));
        unsigned base_off = (unsigned)row0 * 1024u + (unsigned)col0; asm volatile("" : "+v"(base_off));
        u32x4 b[2][4][2];
#pragma unroll
        for (int ai = 0; ai < 2; ++ai)
#pragma unroll
            for (int m = 0; m < 4; ++m)
#pragma unroll
                for (int bj = 0; bj < 2; ++bj) b[ai][m][bj] = *(const u32x4*)(GB2 + base_off + (unsigned)((ai * 128 + m * 16) * 1024 + bj * 128));
#pragma unroll
        for (int ai = 0; ai < 2; ++ai)
#pragma unroll
            for (int m = 0; m < 4; ++m)
#pragma unroll
                for (int bj = 0; bj < 2; ++bj) {
                    const unsigned off = base_off + (unsigned)((ai * 128 + m * 16) * 1024 + bj * 128);
                    const u32x4 gb = b[ai][m][bj];
                    const f32x4 v0 = acc[ai][bj][m][0], v1 = acc[ai][bj][m][1];
                    u32x4 w; w.x = pk_bf16(v0[0] * bf_lo(gb.x), v0[1] * bf_hi(gb.x)); w.y = pk_bf16(v0[2] * bf_lo(gb.y), v0[3] * bf_hi(gb.y));
                    w.z = pk_bf16(v1[0] * bf_lo(gb.z), v1[1] * bf_hi(gb.z)); w.w = pk_bf16(v1[2] * bf_lo(gb.w), v1[3] * bf_hi(gb.w));
                    __builtin_nontemporal_store(w, (u32x4*)(MG + off));
                }
        asm volatile("" ::: "memory");
    }
};
struct EpiP4 {
    static constexpr bool PERM = false, MIDHOOK = false, FUSED = true, DUPSKIP = false;
    const float* x; float* out; const float* gain; float* slots; unsigned* cnt;
    __device__ __forceinline__ void fused(f32x4 (&acc)[2][2][4][2], const pg8::Unit& u, int wr, int wc, int fr, int fq, LAS unsigned char* ldsm, int wid, int lane) const {
        LAS float* P = (LAS float*)(ldsm + 1024);
        LAS float* S = (LAS float*)(ldsm + 1024 + 4096);
        const int row0 = u.pm * 256 + wr * 64 + fr; const int col0 = u.pn * 256 + wc * 32 + 4 * fq;
#pragma unroll
        for (int ai = 0; ai < 2; ++ai)
#pragma unroll
            for (int m = 0; m < 4; ++m) {
                const int row = row0 + ai * 128 + m * 16; float ss = 0.f;
#pragma unroll
                for (int bj = 0; bj < 2; ++bj)
#pragma unroll
                    for (int n = 0; n < 2; ++n) {
                        const f32x4 v = *(const f32x4*)(x + (size_t)row * 1024 + col0 + bj * 128 + n * 16) + acc[ai][bj][m][n];
                        ss += (v[0] * v[0] + v[1] * v[1]) + (v[2] * v[2] + v[3] * v[3]);
                        acc[ai][bj][m][n] = v;
                    }
                ss = xsum_fq(ss);
                if (fq == 0) P[(ai * 128 + wr * 64 + m * 16 + fr) * 4 + wc] = ss;
                if (m & 1) asm volatile("" : "+v"(acc[ai][0][m][0]), "+v"(acc[ai][0][m][1]), "+v"(acc[ai][1][m][0]), "+v"(acc[ai][1][m][1]), "+v"(acc[ai][0][m - 1][0]), "+v"(acc[ai][0][m - 1][1]), "+v"(acc[ai][1][m - 1][0]), "+v"(acc[ai][1][m - 1][1]) :: "memory");
            }
        asm volatile("s_waitcnt lgkmcnt(0)" ::: "memory"); __builtin_amdgcn_s_barrier(); asm volatile("" ::: "memory");
        const int tid = wid * 64 + lane;
        unsigned* pc = cnt + 64 * u.pm;
        if (tid < 256) {
            const f32x4 p = *(const LAS f32x4*)(P + tid * 4);
            const float tot = (p[0] + p[1]) + (p[2] + p[3]);
            __hip_atomic_store(slots + ((size_t)(u.pm * 256 + tid) * 4 + u.pn), tot, __ATOMIC_RELAXED, __HIP_MEMORY_SCOPE_AGENT);
            asm volatile("s_waitcnt vmcnt(0)" ::: "memory");
            if (lane == 0) __hip_atomic_fetch_add(pc, 1u, __ATOMIC_RELAXED, __HIP_MEMORY_SCOPE_AGENT);
        }
        if (wid == 0) {
            unsigned spins = 0;
            while ((unsigned)__builtin_amdgcn_readfirstlane(__hip_atomic_load(pc, __ATOMIC_RELAXED, __HIP_MEMORY_SCOPE_AGENT)) < 16u) { __builtin_amdgcn_s_sleep(2); if (++spins > (1u << 24)) break; }
            __builtin_amdgcn_fence(__ATOMIC_ACQUIRE, "agent");
        }
        asm volatile("s_waitcnt vmcnt(0) lgkmcnt(0)" ::: "memory"); __builtin_amdgcn_s_barrier(); asm volatile("" ::: "memory");
        if (tid < 256) {
            const float* sl = slots + (size_t)(u.pm * 256 + tid) * 4;
            const float a0 = __hip_atomic_load(sl + 0, __ATOMIC_RELAXED, __HIP_MEMORY_SCOPE_AGENT), a1 = __hip_atomic_load(sl + 1, __ATOMIC_RELAXED, __HIP_MEMORY_SCOPE_AGENT);
            const float a2 = __hip_atomic_load(sl + 2, __ATOMIC_RELAXED, __HIP_MEMORY_SCOPE_AGENT), a3 = __hip_atomic_load(sl + 3, __ATOMIC_RELAXED, __HIP_MEMORY_SCOPE_AGENT);
            S[tid] = 1.0f / sqrtf(((a0 + a1) + (a2 + a3)) * (1.0f / 1024.0f) + EPS);
        }
        asm volatile("s_waitcnt vmcnt(0) lgkmcnt(0)" ::: "memory"); __builtin_amdgcn_s_barrier(); asm volatile("" ::: "memory");
        f32x4 gn[2][2];
#pragma unroll
        for (int bj = 0; bj < 2; ++bj)
#pragma unroll
            for (int n = 0; n < 2; ++n) gn[bj][n] = *(const f32x4*)(gain + col0 + bj * 128 + n * 16);
#pragma unroll
        for (int ai = 0; ai < 2; ++ai)
#pragma unroll
            for (int m = 0; m < 4; ++m) {
                const int rl = ai * 128 + wr * 64 + m * 16 + fr; const float r = S[rl]; const size_t ro = (size_t)(u.pm * 256 + rl) * 1024 + col0;
#pragma unroll
                for (int bj = 0; bj < 2; ++bj)
#pragma unroll
                    for (int n = 0; n < 2; ++n) __builtin_nontemporal_store(acc[ai][bj][m][n] * r * gn[bj][n], (f32x4*)(out + ro + bj * 128 + n * 16));
            }
    }
};

__device__ __forceinline__ void transpose_item(const float* W, int N, bf16_t* WT, int ldk, int kofs, int dst_row0, LAS float* scr, int k0, int n0, int lane) {
#pragma unroll 8
    for (int i = 0; i < 32; ++i) { const int kk = 2 * i + (lane >> 5); scr[kk * 33 + (lane & 31)] = W[(size_t)(k0 + kk) * N + n0 + (lane & 31)]; }
    asm volatile("s_waitcnt lgkmcnt(0)" ::: "memory");
    const int c = lane & 7;
#pragma unroll
    for (int j = 0; j < 4; ++j) { const int n = (lane >> 3) + 8 * j; const LAS float* s = scr + (8 * c) * 33 + n;
        u32x4 o; o.x = pk_bf16(s[0 * 33], s[1 * 33]); o.y = pk_bf16(s[2 * 33], s[3 * 33]); o.z = pk_bf16(s[4 * 33], s[5 * 33]); o.w = pk_bf16(s[6 * 33], s[7 * 33]);
        *(u32x4*)(WT + (size_t)(dst_row0 + n) * ldk + kofs + k0 + 8 * c) = o; }
    asm volatile("s_waitcnt lgkmcnt(0)" ::: "memory");
}
__device__ __forceinline__ int win_dst_row(int n0) {
    const int seg = n0 >> 10, within = n0 & 1023, j = within >> 7, i = within & 127;
    if (seg == 0) return 256 * j + i;
    if (seg == 2) return 256 * j + 128 + i;
    if (seg == 1) return 2048 + within;
    if (seg <= 6) return seg * 1024 + within;
    if (seg == 7) return 7168 + 256 * j + i;
    return 7168 + 256 * j + 128 + i;
}

constexpr int ATT_KBUF = 16384, ATT_VBUF = 20480, ATT_K0 = 0, ATT_V0 = 2 * ATT_KBUF, ATT_FLAGS = ATT_V0 + 2 * ATT_VBUF;
#ifndef SB_EARLY_EXIT
#define SB_EARLY_EXIT 1
#endif
__device__ __forceinline__ s16x4 tr16(const LAS unsigned char* p) { return __builtin_bit_cast(s16x4, __builtin_amdgcn_ds_read_tr16_b64_v4i16((LAS s16x4*)p)); }

__device__ __forceinline__ void att_tile(const LAS unsigned char* Kb, const LAS unsigned char* Vb, int t, int qw0, int myq, int hi, int kperm, unsigned vlane,
                                         const bf16x8 (&qf)[8], f32x16 (&o)[4], float& carry, bool walive) {
#pragma unroll
        for (int sbi = 0; sbi < 2; ++sbi) {
            const int sb = 1 - sbi; const int kb = 64 * t + 32 * sb;
            if (kb < qw0 + 31 && walive) {
                const int krow = 32 * sb + kperm; const int swz = (krow & 7) + 8 * ((krow >> 4) & 1);
                const LAS unsigned char* kp = Kb + krow * 256;
                f32x16 s;
#pragma unroll
                for (int r = 0; r < 16; ++r) s[r] = 0.f;
#pragma unroll
                for (int kk = 0; kk < 8; ++kk) { const bf16x8 a = *(const LAS bf16x8*)(kp + (((2 * kk + hi) ^ swz) * 16)); s = __builtin_amdgcn_mfma_f32_32x32x16_bf16(a, qf[kk], s, 0, 0, 0); }
                const bool needmask = (kb + 31 >= qw0);
                const int key0 = kb + 16 * hi;
                float wl[16]; float Ploc = 1.f;
                if (needmask) {
#pragma unroll
                    for (int r = 15; r >= 0; --r) {
                        float beta = rcpf_(1.f + ex2(-s[r]));
                        if (key0 + r >= myq) beta = 0.f;
                        wl[r] = beta * Ploc; Ploc -= wl[r];
                    }
                } else {
#pragma unroll
                    for (int r = 15; r >= 0; --r) { wl[r] = Ploc * rcpf_(1.f + ex2(-s[r])); Ploc -= wl[r]; }
                }
                const float Tother = __shfl_xor(Ploc, 32);
                const float cstart = carry * (hi == 0 ? Tother : 1.f);
                carry = carry * (Ploc * Tother);
                u32x4 w0, w1;
                w0.x = pk_bf16(wl[0] * cstart, wl[1] * cstart); w0.y = pk_bf16(wl[2] * cstart, wl[3] * cstart); w0.z = pk_bf16(wl[4] * cstart, wl[5] * cstart); w0.w = pk_bf16(wl[6] * cstart, wl[7] * cstart);
                w1.x = pk_bf16(wl[8] * cstart, wl[9] * cstart); w1.y = pk_bf16(wl[10] * cstart, wl[11] * cstart); w1.z = pk_bf16(wl[12] * cstart, wl[13] * cstart); w1.w = pk_bf16(wl[14] * cstart, wl[15] * cstart);
                const bf16x8 wb0 = __builtin_bit_cast(bf16x8, w0), wb1 = __builtin_bit_cast(bf16x8, w1);
                const LAS unsigned char* vp = Vb + (32 * sb) * 320 + vlane;
#pragma unroll
                for (int dt = 0; dt < 4; ++dt) {
                    const s16x4 a0 = tr16(vp + dt * 64), a1 = tr16(vp + 4 * 320 + dt * 64);
                    const s16x4 c0 = tr16(vp + 8 * 320 + dt * 64), c1 = tr16(vp + 12 * 320 + dt * 64);
                    const bf16x8 fa = __builtin_shufflevector(a0, a1, 0, 1, 2, 3, 4, 5, 6, 7), fc = __builtin_shufflevector(c0, c1, 0, 1, 2, 3, 4, 5, 6, 7);
                    o[dt] = __builtin_amdgcn_mfma_f32_32x32x16_bf16(fa, wb0, o[dt], 0, 0, 0);
                    o[dt] = __builtin_amdgcn_mfma_f32_32x32x16_bf16(fc, wb1, o[dt], 0, 0, 0);
                }
            }
        }
}

__device__ __forceinline__ void attn_unit(LAS unsigned char* lds, int b, int h, int qt, bf16_t* YAB, const bf16_t* KB, const bf16_t* VB, const bf16_t* ZB, bool do_store) {
    const int tid = threadIdx.x, lane = tid & 63, wid = __builtin_amdgcn_readfirstlane(tid >> 6), r32 = lane & 31, hi = lane >> 5;
    const int tok0 = b * SEQ, q0 = qt * 256, qw0 = q0 + 32 * wid, myq = qw0 + r32;
    bf16x8 qf[8];
    { const bf16_t* qp = YAB + (size_t)(tok0 + myq) * 2048 + 1024 + h * HD + 8 * hi;
#pragma unroll
      for (int kk = 0; kk < 8; ++kk) qf[kk] = *(const bf16x8*)(qp + 16 * kk); }
    const int skey0 = tid >> 4, sc0 = tid & 15; const int sswz = (skey0 & 7) + 8 * ((skey0 >> 4) & 1);
    const unsigned kdst0 = (unsigned)(skey0 * 256 + ((sc0 ^ sswz) * 16)), vdst0 = (unsigned)(skey0 * 320 + sc0 * 16);
    const bf16_t* kg = KB + (size_t)tok0 * 1024 + h * HD; const bf16_t* vg = VB + (size_t)tok0 * 1024 + h * HD;
    u32x4 kA[2], vA[2], kB[2], vB[2];
    const int T0 = qt * 4 + 3;
#define ATT_LOAD(KR, VR, tile) do { _Pragma("unroll") for (int i = 0; i < 2; ++i) { const size_t go = (size_t)(64 * (tile) + skey0 + 32 * i) * 1024 + 8 * sc0; KR[i] = *(const u32x4*)(kg + go); VR[i] = *(const u32x4*)(vg + go); } } while (0)
#define ATT_WRITE(KR, VR, buf) do { _Pragma("unroll") for (int i = 0; i < 2; ++i) { *(LAS u32x4*)(lds + ATT_K0 + (buf) * ATT_KBUF + kdst0 + 8192 * i) = KR[i]; *(LAS u32x4*)(lds + ATT_V0 + (buf) * ATT_VBUF + vdst0 + 10240 * i) = VR[i]; } } while (0)
    ATT_LOAD(kA, vA, T0); ATT_LOAD(kB, vB, T0 - 1);
    ATT_WRITE(kA, vA, 0);
    __syncthreads();
    f32x16 o[4];
#pragma unroll
    for (int d = 0; d < 4; ++d)
#pragma unroll
        for (int r = 0; r < 16; ++r) o[d][r] = 0.f;
    float carry = 1.f; bool walive = true;
    const int kperm = 16 * ((r32 >> 2) & 1) + (r32 & 3) + 4 * (r32 >> 3);
    const int i16 = lane & 15, qd = i16 >> 2, pp = i16 & 3, blk = (lane >> 4) & 1;
    const unsigned vlane = (unsigned)((16 * hi + qd) * 320 + (16 * blk + 4 * pp) * 2);
    int cur = 0; int it = 0; int t = T0;
#define ATT_STEP(KF, VF, KH, VH) { \
        if (t >= 2) ATT_LOAD(KF, VF, t - 2); \
        att_tile(lds + ATT_K0 + cur * ATT_KBUF, lds + ATT_V0 + cur * ATT_VBUF, t, qw0, myq, hi, kperm, vlane, qf, o, carry, walive); \
        if (t >= 1) ATT_WRITE(KH, VH, cur ^ 1); \
        walive = __any(carry > 0x1p-134f);     \
        if (lane == 0) ((LAS unsigned*)(lds + ATT_FLAGS))[(it & 1) * 8 + wid] = walive ? 1u : 0u; \
        __syncthreads(); \
        { const LAS unsigned* fl = (const LAS unsigned*)(lds + ATT_FLAGS) + (it & 1) * 8; \
          const unsigned any = fl[0] | fl[1] | fl[2] | fl[3] | fl[4] | fl[5] | fl[6] | fl[7]; \
          if (any == 0u || t == 0) break; }     \
        --t; cur ^= 1; ++it; }
    for (;;) {
        ATT_STEP(kA, vA, kB, vB)
        ATT_STEP(kB, vB, kA, vA)
    }
#undef ATT_STEP
#undef ATT_LOAD
#undef ATT_WRITE
    { const bf16_t* zp = ZB + (size_t)(tok0 + myq) * 1024 + h * HD + 8 * hi; bf16_t* op = YAB + (size_t)(tok0 + myq) * 2048 + 1024 + h * HD + 8 * hi;
#pragma unroll
      for (int dt = 0; dt < 4; ++dt)
#pragma unroll
          for (int p = 0; p < 2; ++p) {
              const u32x4 z = *(const u32x4*)(zp + 32 * dt + 16 * p);
              float v[8];
#pragma unroll
              for (int j = 0; j < 4; ++j) {
                  const auto rr = __builtin_amdgcn_permlane32_swap(__float_as_uint(o[dt][8 * p + j]), __float_as_uint(o[dt][8 * p + 4 + j]), false, false);
                  v[j] = __uint_as_float(rr[0]); v[4 + j] = __uint_as_float(rr[1]);
              }
              u32x4 w; w.x = pk_bf16(v[0] * bf_lo(z.x), v[1] * bf_hi(z.x)); w.y = pk_bf16(v[2] * bf_lo(z.y), v[3] * bf_hi(z.y));
              w.z = pk_bf16(v[4] * bf_lo(z.z), v[5] * bf_hi(z.z)); w.w = pk_bf16(v[6] * bf_lo(z.w), v[7] * bf_hi(z.w));
              if (do_store) *(u32x4*)(op + 32 * dt + 16 * p) = w;
          } }
}

constexpr int GM_V = 0, GM_RSTD = 40960, GM_STG = 41472, GM_STGP = 132;
__device__ __forceinline__ void gmlp_phase(LAS unsigned char* lds, int cu, int G, bf16_t* YAB, const bf16_t* VA, const float* ssv, const float* w_s, const float* b_s, const float* norm_v) {
    const int tid = threadIdx.x, lane = tid & 63, wid = __builtin_amdgcn_readfirstlane(tid >> 6), r32 = lane & 31, hi = lane >> 5;
    const int ttile = wid & 3, chalf = wid >> 2; const int t = 32 * ttile + r32;
    const bool fixg = (G & 7) == 0;
    const int nun = fixg ? (512 - (cu >> 3) + (G >> 3) - 1) / (G >> 3) : (4096 - cu + G - 1) / G;
    if (nun <= 0) return;
#define GM_UNIT(i, p_, g_) do { if (fixg) { p_ = (cu >> 3) + (G >> 3) * (i); g_ = cu & 7; } else { const int v_ = cu + G * (i); p_ = v_ >> 3; g_ = v_ & 7; } } while (0)
    u32x4 vld[4], uzC[4]; f32x4 ssl[4];
    f32x4 wa[8], wb[8], bs[4]; float nv[2]; int gcur = -1;
#define GM_LOADS(p_, g_) do { const int tok_ = ((p_) >> 4) * SEQ + ((p_) & 15) * CHUNK; \
        _Pragma("unroll") for (int i = 0; i < 4; ++i) { const int id = tid + 512 * i, s_ = id >> 4, c_ = id & 15; \
            vld[i] = *(const u32x4*)(VA + (size_t)(tok_ + s_) * 1024 + (g_) * 128 + 8 * c_); } \
        if (tid < 128) { const f32x4* p4 = (const f32x4*)(ssv + (size_t)(tok_ + tid) * 16); ssl[0] = p4[0]; ssl[1] = p4[1]; ssl[2] = p4[2]; ssl[3] = p4[3]; } } while (0)
    int p, g; GM_UNIT(0, p, g);
    GM_LOADS(p, g);
    const int i16 = lane & 15, qd = i16 >> 2, pp = i16 & 3, blk = (lane >> 4) & 1;
    const LAS unsigned char* vp = lds + GM_V + (8 * hi + qd) * 320 + (64 * chalf + 16 * blk + 4 * pp) * 2;
    const LAS float* rs = (const LAS float*)(lds + GM_RSTD);
    const int nks = 2 * (ttile + 1);
    for (int iu = 0; iu < nun; ++iu) {
        const int tok0 = (p >> 4) * SEQ + (p & 15) * CHUNK;
        if (g != gcur) {
            const float* wrow = w_s + ((size_t)g * 128 + t) * 128 + 8 * hi;
#pragma unroll
            for (int kk = 0; kk < 8; ++kk) { wa[kk] = *(const f32x4*)(wrow + 16 * kk); wb[kk] = *(const f32x4*)(wrow + 16 * kk + 4); }
#pragma unroll
            for (int ct = 0; ct < 2; ++ct) nv[ct] = norm_v[g * 128 + 64 * chalf + 32 * ct + r32];
#pragma unroll
            for (int g4 = 0; g4 < 4; ++g4) bs[g4] = *(const f32x4*)(b_s + g * 128 + 32 * ttile + 8 * g4 + 4 * hi);
            gcur = g;
        }
#pragma unroll
        for (int i = 0; i < 4; ++i) { const int id = tid + 512 * i, s_ = id >> 4, c_ = id & 15; *(LAS u32x4*)(lds + GM_V + s_ * 320 + c_ * 16) = vld[i]; }
        if (tid < 128) {
            const float sum = ((ssl[0][0] + ssl[0][1]) + (ssl[0][2] + ssl[0][3])) + ((ssl[1][0] + ssl[1][1]) + (ssl[1][2] + ssl[1][3])) + ((ssl[2][0] + ssl[2][1]) + (ssl[2][2] + ssl[2][3])) + ((ssl[3][0] + ssl[3][1]) + (ssl[3][2] + ssl[3][3]));
            ((LAS float*)(lds + GM_RSTD))[tid] = 1.0f / sqrtf(sum * (1.0f / 1024.0f) + EPS); }
        __syncthreads();
        int pn_ = p, gn_ = g;
#pragma unroll
        for (int i = 0; i < 4; ++i) { const int id = tid + 512 * i, s_ = id >> 4, c_ = id & 15; uzC[i] = *(const u32x4*)(YAB + (size_t)(tok0 + s_) * 2048 + g * 128 + 8 * c_); }
        if (iu + 1 < nun) { GM_UNIT(iu + 1, pn_, gn_); GM_LOADS(pn_, gn_); }
        f32x16 acc[2];
#pragma unroll
        for (int ct = 0; ct < 2; ++ct)
#pragma unroll
            for (int r = 0; r < 16; ++r) acc[ct][r] = 0.f;
#pragma unroll
        for (int kk = 0; kk < 8; ++kk) {
            if (kk < nks) {
                const int s0 = 16 * kk + 8 * hi;
                const f32x4 ra = *(const LAS f32x4*)(rs + s0), rb = *(const LAS f32x4*)(rs + s0 + 4);
                float a8[8];
#pragma unroll
                for (int j = 0; j < 4; ++j) { a8[j] = (s0 + j <= t) ? wa[kk][j] * ra[j] : 0.f; a8[4 + j] = (s0 + 4 + j <= t) ? wb[kk][j] * rb[j] : 0.f; }
                u32x4 aw; aw.x = pk_bf16(a8[0], a8[1]); aw.y = pk_bf16(a8[2], a8[3]); aw.z = pk_bf16(a8[4], a8[5]); aw.w = pk_bf16(a8[6], a8[7]);
                const bf16x8 af = __builtin_bit_cast(bf16x8, aw);
#pragma unroll
                for (int ct = 0; ct < 2; ++ct) {
                    const s16x4 lo = tr16(vp + (16 * kk) * 320 + ct * 64), hi4 = tr16(vp + (16 * kk + 4) * 320 + ct * 64);
                    const bf16x8 bfr = __builtin_shufflevector(lo, hi4, 0, 1, 2, 3, 4, 5, 6, 7);
                    acc[ct] = __builtin_amdgcn_mfma_f32_32x32x16_bf16(af, bfr, acc[ct], 0, 0, 0);
                }
            }
        }
        { LAS float* stg = (LAS float*)(lds + GM_STG);
#pragma unroll
          for (int ct = 0; ct < 2; ++ct) { const int c = 64 * chalf + 32 * ct + r32;
#pragma unroll
              for (int g4 = 0; g4 < 4; ++g4) { const int tb = 32 * ttile + 8 * g4 + 4 * hi;
#pragma unroll
                  for (int j = 0; j < 4; ++j) stg[(tb + j) * GM_STGP + c] = acc[ct][4 * g4 + j] * nv[ct] + bs[g4][j]; } } }
        __syncthreads();
#pragma unroll
        for (int i = 0; i < 4; ++i) { const int id = tid + 512 * i, tt = id >> 4, cc = id & 15;
            const LAS float* sp = (const LAS float*)(lds + GM_STG) + tt * GM_STGP + 8 * cc; const f32x4 m0 = *(const LAS f32x4*)sp, m1 = *(const LAS f32x4*)(sp + 4);
            bf16_t* gp = YAB + (size_t)(tok0 + tt) * 2048 + g * 128 + 8 * cc; const u32x4 uz = uzC[i];
            u32x4 w; w.x = pk_bf16(bf_lo(uz.x) * m0[0], bf_hi(uz.x) * m0[1]); w.y = pk_bf16(bf_lo(uz.y) * m0[2], bf_hi(uz.y) * m0[3]);
            w.z = pk_bf16(bf_lo(uz.z) * m1[0], bf_hi(uz.z) * m1[1]); w.w = pk_bf16(bf_lo(uz.w) * m1[2], bf_hi(uz.w) * m1[3]);
            *(u32x4*)gp = w; }
        __syncthreads();
        p = pn_; g = gn_;
    }
#undef GM_UNIT
#undef GM_LOADS
}


#define XB_TMO      128
#define XB_XCNT(j)  (256  + 64 * (j))
#define XB_XSUB(j)  (1280 + 64 * (j))
#define XB_XGEN(j)  (2304 + 64 * (j))
#define XB_TOP      3328
#define XB_TOPGEN   3392
#define XCD_BAR_WORDS 3456
#define XB_SPIN_CAP (1u << 18)
__device__ __forceinline__ unsigned xb_ld(unsigned* p)              { return __hip_atomic_load(p, __ATOMIC_RELAXED, __HIP_MEMORY_SCOPE_AGENT); }
__device__ __forceinline__ unsigned xb_add(unsigned* p, unsigned v) { return __hip_atomic_fetch_add(p, v, __ATOMIC_RELAXED, __HIP_MEMORY_SCOPE_AGENT); }
__device__ __forceinline__ unsigned xb_xcc_id() { return (unsigned)__builtin_amdgcn_s_getreg((3 << 11) | 20) & 0xFu; }
#define XB_SPIN(cond, bar) do { unsigned _sp = 0; while (cond) { __builtin_amdgcn_s_sleep(1); \
    if ((++_sp & 255u) == 0u) { if (xb_ld(&(bar)[XB_TMO])) break; if (_sp > XB_SPIN_CAP) { atomicAdd(&(bar)[XB_TMO], 1u); break; } } } } while (0)
struct XcdBarrier { unsigned* bar; unsigned x; volatile LAS unsigned* st; };
__device__ __forceinline__ XcdBarrier xcd_barrier_post(unsigned* bar, volatile LAS unsigned* st) {
    XcdBarrier b; b.bar = bar; b.x = xb_xcc_id(); b.st = st;
    if (threadIdx.x == 0) (void)xb_add(&bar[XB_XCNT(b.x)], 1u);
    return b;
}
__device__ __forceinline__ void xcd_barrier_complete(unsigned* bar, unsigned x, unsigned& nloc, unsigned& nx) {
    const unsigned G = gridDim.x * gridDim.y * gridDim.z;
    unsigned sum, cnt, mine, sp = 0u;
    for (;;) {
        sum = 0u; cnt = 0u; mine = 0u;
#pragma unroll
        for (unsigned j = 0; j < 16; ++j) { const unsigned c = xb_ld(&bar[XB_XCNT(j)]); sum += c; cnt += (c > 0u) ? 1u : 0u; mine = (j == x) ? c : mine; }
        if (sum == G) break;
        __builtin_amdgcn_s_sleep(1);
        if ((++sp & 255u) == 0u) { if (xb_ld(&bar[XB_TMO])) break; if (sp > XB_SPIN_CAP) { atomicAdd(&bar[XB_TMO], 1u); break; } }
    }
    nloc = mine > 0u ? mine : 1u; nx = cnt > 0u ? cnt : 1u;
}
__device__ __forceinline__ void xcd_barrier(unsigned* bar_, volatile LAS unsigned* st_) {
    asm volatile("s_waitcnt vmcnt(0)" ::: "memory");
    __syncthreads();
    if (threadIdx.x == 0) {
        XcdBarrier b; b.bar = bar_; b.x = xb_xcc_id(); b.st = st_;
        unsigned* bar = b.bar;
        __builtin_amdgcn_s_waitcnt(0);
        unsigned nloc = b.st[0], nx = b.st[1];
        if (nloc == 0u) { xcd_barrier_complete(bar, b.x, nloc, nx); b.st[0] = nloc; b.st[1] = nx; }
        const unsigned old = xb_add(&bar[XB_XSUB(b.x)], 1u);
        const unsigned gen = old / nloc;
        if (old + 1u == (gen + 1u) * nloc) {
            __builtin_amdgcn_fence(__ATOMIC_RELEASE, "agent");
            asm volatile("s_waitcnt vmcnt(0)" ::: "memory");
            const unsigned og = xb_add(&bar[XB_TOP], 1u);
            const unsigned tg = og / nx;
            if (og + 1u == (tg + 1u) * nx) xb_add(&bar[XB_TOPGEN], 1u);
            else XB_SPIN(xb_ld(&bar[XB_TOPGEN]) == tg, bar);
            __builtin_amdgcn_fence(__ATOMIC_ACQUIRE, "agent");
            xb_add(&bar[XB_XGEN(b.x)], 1u);
            asm volatile("s_waitcnt vmcnt(0)" ::: "memory");
        } else {
            XB_SPIN(xb_ld(&bar[XB_XGEN(b.x)]) == gen, bar);
            __builtin_amdgcn_fence(__ATOMIC_ACQUIRE, "agent");
            asm volatile("s_waitcnt vmcnt(0)" ::: "memory");
        }
    }
    __syncthreads();
}

struct Args { const float* in[10]; float* out; unsigned char* ws; };
#ifndef PHM
#define PHM 31
#endif
#ifndef ATT_REP
#define ATT_REP 1
#endif
#ifndef GM_REP
#define GM_REP 1
#endif
#ifndef REP0
#define REP0 1
#endif
#ifndef REP1
#define REP1 1
#endif
#ifndef REP3
#define REP3 1
#endif
#ifndef REP4
#define REP4 1
#endif
#ifndef P2M
#define P2M 3
#endif
constexpr int N_ATT = BATCH * NH * (SEQ / 256), N_GM = BATCH * (SEQ / CHUNK) * NG;

__global__ void __launch_bounds__(512, 2) fwd_megakernel(Args args) {
    extern __shared__ __attribute__((aligned(16))) unsigned char lds_raw[];
    LAS unsigned char* lds = (LAS unsigned char*)lds_raw;
    cg::grid_group grid = cg::this_grid();
    const int tid = threadIdx.x, lane = tid & 63, wave = __builtin_amdgcn_readfirstlane(tid >> 6);
    const int G = gridDim.x;
    const float* x = args.in[0]; const float* norm_in = args.in[1]; const float* w_in = args.in[2]; const float* norm_v = args.in[3]; const float* w_s = args.in[4];
    const float* b_s = args.in[5]; const float* w_o_gmlp = args.in[6]; const float* w_o_sb = args.in[7]; const float* w_out = args.in[8]; const float* norm_final = args.in[9];
    unsigned char* ws = args.ws; float* out = args.out;
    unsigned* ctl = (unsigned*)(ws + WS_CTL);
    volatile LAS unsigned* xst = (volatile LAS unsigned*)(lds + LDS_MISC + 64);
    if (tid < 2) xst[tid] = 0u;
    __syncthreads();
    for (unsigned w = blockIdx.x * 512u + tid; w < CTL_BYTES / 4; w += gridDim.x * 512u) ctl[w] = 0u;
    bf16_t* WIN = (bf16_t*)(ws + WS_WIN); bf16_t* WCAT = (bf16_t*)(ws + WS_WCAT); bf16_t* WOUT = (bf16_t*)(ws + WS_WOUT);
    float* ssv = (float*)(ws + WS_SSV); float* ssf = (float*)(ws + WS_SSF);
    bf16_t* YAB = (bf16_t*)(ws + WS_YAB); bf16_t* VA = (bf16_t*)(ws + WS_VA); bf16_t* VB = (bf16_t*)(ws + WS_VB); bf16_t* ZB = (bf16_t*)(ws + WS_ZB);
    bf16_t* GA = (bf16_t*)(ws + WS_GA); bf16_t* GB = (bf16_t*)(ws + WS_GB); bf16_t* MG = VA;
    bf16_t* XN = (bf16_t*)out; bf16_t* KB = (bf16_t*)out + (size_t)M * 1024;

    for (int rep_ = 0; rep_ < REP0; ++rep_) {
        LAS float* scr = (LAS float*)(lds + wave * 16384);
        const int gw = blockIdx.x * 8 + wave, NGW = G * 8;
        constexpr int I_IN = 16 * (NIN / 32), I_SQ = 16 * 32;
        for (int it = gw; it < I_IN + 3 * I_SQ; it += NGW) {
            int r = it;
            if (r < I_IN) { const int kb = r / (NIN / 32), nb = r % (NIN / 32); transpose_item(w_in, NIN, WIN, 1024, 0, win_dst_row(32 * nb), scr, 64 * kb, 32 * nb, lane); continue; }
            r -= I_IN; const int which = r / I_SQ; r -= which * I_SQ; const int kb = r / 32, nb = r % 32;
            if (which == 0) transpose_item(w_o_gmlp, 1024, WCAT, 2048, 0, 32 * nb, scr, 64 * kb, 32 * nb, lane);
            else if (which == 1) transpose_item(w_o_sb, 1024, WCAT, 2048, 1024, 32 * nb, scr, 64 * kb, 32 * nb, lane);
            else transpose_item(w_out, 1024, WOUT, 1024, 0, 32 * nb, scr, 64 * kb, 32 * nb, lane);
        }
        f32x4 gn[4];
#pragma unroll
        for (int j = 0; j < 4; ++j) gn[j] = *((const f32x4*)norm_in + lane + 64 * j);
        for (int m = gw; m < M; m += 4 * NGW) {
            f32x4 v[4][4]; float sq[4];
#pragma unroll
            for (int q = 0; q < 4; ++q) { const int mq = (m + q * NGW < M) ? m + q * NGW : m; const f32x4* xr = (const f32x4*)(x + (size_t)mq * DM) + lane;
#pragma unroll
                for (int j = 0; j < 4; ++j) v[q][j] = xr[64 * j]; }
#pragma unroll
            for (int q = 0; q < 4; ++q) { float a = 0.f;
#pragma unroll
                for (int j = 0; j < 4; ++j) a += (v[q][j][0] * v[q][j][0] + v[q][j][1] * v[q][j][1]) + (v[q][j][2] * v[q][j][2] + v[q][j][3] * v[q][j][3]);
                sq[q] = a; }
#pragma unroll
            for (int o = 1; o < 64; o <<= 1) {
#pragma unroll
                for (int q = 0; q < 4; ++q) sq[q] += __shfl_xor(sq[q], o); }
#pragma unroll
            for (int q = 0; q < 4; ++q) if (m + q * NGW < M) {
                const float r = 1.0f / sqrtf(sq[q] * (1.0f / DM) + EPS);
                u32x2* o8 = (u32x2*)(XN + (size_t)(m + q * NGW) * DM) + lane;
#pragma unroll
                for (int j = 0; j < 4; ++j) { u32x2 w; w.x = pk_bf16(v[q][j][0] * r * gn[j][0], v[q][j][1] * r * gn[j][1]); w.y = pk_bf16(v[q][j][2] * r * gn[j][2], v[q][j][3] * r * gn[j][3]); o8[64 * j] = w; }
            }
        }
    }
    grid.sync();
    (void)xcd_barrier_post(ctl + 20480, xst);

    {
        pg8::Gemm g{XN, WIN, M, NIN, DM}; pg8::StaticOrder S; S.init(M, NIN, G, (int)blockIdx.x, REP1, KDUP);
        EpiP1 E{YAB, VA, KB, VB, ZB, GA, GB, ssv, (LAS float*)(lds + LDS_MISC + 1024)};
        pg8::gemm_phase<EpiP1, pg8::StaticOrder>(lds, g, S, E);
    }
    xcd_barrier((unsigned*)((unsigned char*)args.ws + WS_CTL) + 20480, (volatile LAS unsigned*)(lds + LDS_MISC + 64));

    if (PHM & 4) {
        LAS int* uw = (LAS int*)(lds + LDS_MISC);
        if (tid == 0) uw[0] = (int)atomicAdd(ctl + 0, 1u);
        __syncthreads();
        int u = uw[0];
        for (int k = 0; u < N_ATT; ++k) {
            int unext = 0;
            if (tid == 0) unext = (int)atomicAdd(ctl + 0, 1u);
            {
                const int cls = 3 - (u >> 9), r = u & 511; const int qt = 7 - (r >> 6), j = r & 63; const int b = 4 * (j >> 3) + cls, h = j & 7;
                attn_unit(lds, b, h, qt, YAB, KB, VB, ZB, true); }
            if (tid == 0) uw[(k + 1) & 1] = unext;
            __syncthreads();
            u = uw[(k + 1) & 1];
        }
        __syncthreads();
        gmlp_phase(lds, (int)blockIdx.x, G, YAB, VA, ssv, w_s, b_s, norm_v);
    }
    xcd_barrier((unsigned*)((unsigned char*)args.ws + WS_CTL) + 20480, (volatile LAS unsigned*)(lds + LDS_MISC + 64));

    {
        pg8::Gemm g{YAB, WCAT, M, DM, 2048}; pg8::StaticOrder S; S.init(M, DM, G, (int)blockIdx.x, REP3);
        EpiP3 E{GA, GB, MG};
        pg8::gemm_phase<EpiP3, pg8::StaticOrder>(lds, g, S, E);
    }
    xcd_barrier((unsigned*)((unsigned char*)args.ws + WS_CTL) + 20480, (volatile LAS unsigned*)(lds + LDS_MISC + 64));

    {
        pg8::Gemm g{MG, WOUT, M, DM, DM}; pg8::StaticOrder S; S.init(M, DM, G, (int)blockIdx.x, REP4);
        EpiP4 E{x, out, norm_final, ssf, ctl + 1024};
        pg8::gemm_phase<EpiP4, pg8::StaticOrder>(lds, g, S, E);
    }
}

extern "C" void kernel_launch(void* const* d_in, const int* in_sizes, int n_in, void* d_out, int out_size, void* d_ws, size_t ws_size, hipStream_t stream) {
    static int grid_blocks = 0;
    if (grid_blocks == 0) {
        if (n_in != 10 || in_sizes[0] != M * DM || out_size != M * DM || ws_size < WS_END) { fprintf(stderr, "kernel_launch: unexpected shapes / workspace (%d inputs, ws %zu)\n", n_in, ws_size); grid_blocks = -1; return; }
        int dev = 0, cus = 0, per_cu = 0;
        hipGetDevice(&dev); hipDeviceGetAttribute(&cus, hipDeviceAttributeMultiprocessorCount, dev);
        hipFuncSetAttribute((const void*)fwd_megakernel, hipFuncAttributeMaxDynamicSharedMemorySize, LDS_BYTES);
        hipOccupancyMaxActiveBlocksPerMultiprocessor(&per_cu, (const void*)fwd_megakernel, 512, LDS_BYTES);
        if (per_cu < 1) per_cu = 1;
        grid_blocks = cus * per_cu;
        (void)hipGetLastError();
    }
    if (grid_blocks < 0) return;
    Args a{};
    for (int i = 0; i < 10; ++i) a.in[i] = (const float*)d_in[i];
    a.out = (float*)d_out; a.ws = (unsigned char*)d_ws;
    void* kargs[] = {&a};
    hipError_t e = hipLaunchCooperativeKernel((const void*)fwd_megakernel, dim3(grid_blocks), dim3(512), kargs, LDS_BYTES, stream);
    if (e != hipSuccess) fprintf(stderr, "cooperative launch failed: %s (grid %d)\n", hipGetErrorString(e), grid_blocks);
}
```

```cpp
#include <hip/hip_runtime.h>
#include <hip/hip_cooperative_groups.h>
#include <cstdio>
#include <cstdint>
namespace cg = cooperative_groups;

#define LAS __attribute__((address_space(3)))
#define GAS __attribute__((address_space(1)))
typedef unsigned short bf16_t;
typedef short bf16x8 __attribute__((ext_vector_type(8)));
typedef short s16x4 __attribute__((ext_vector_type(4)));
typedef float f32x4 __attribute__((ext_vector_type(4)));
typedef float f32x2 __attribute__((ext_vector_type(2)));
typedef float f32x16 __attribute__((ext_vector_type(16)));
typedef unsigned u32x4 __attribute__((ext_vector_type(4)));
typedef unsigned u32x2 __attribute__((ext_vector_type(2)));
typedef __bf16 bf16x2_t __attribute__((ext_vector_type(2)));

constexpr int DM = 1024, BATCH = 32, SEQ = 2048, M = BATCH * SEQ;
constexpr int NIN = 9216, NH = 8, HD = 128, CHUNK = 128, NG = 8;
constexpr float EPS = 1e-6f;
constexpr float LOG2E = 1.4426950408889634f;

constexpr size_t MiB = 1u << 20;
constexpr size_t WS_CTL = 0, CTL_BYTES = 131072;
constexpr size_t WS_WIN = 2 * MiB, WS_WCAT = 20 * MiB, WS_WOUT = 24 * MiB, WS_SSV = 26 * MiB, WS_SSF = 30 * MiB;
constexpr size_t WS_YAB = 64 * MiB, WS_VA = 320 * MiB, WS_VB = 448 * MiB, WS_ZB = 576 * MiB, WS_GA = 704 * MiB, WS_GB = 832 * MiB, WS_END = 960 * MiB;
constexpr int LDS_RING = 131072, LDS_MISC = 131072, LDS_BYTES = 147456;

__device__ __forceinline__ float ex2(float x) { return __builtin_amdgcn_exp2f(x); }
__device__ __forceinline__ float rcpf_(float x) { return __builtin_amdgcn_rcpf(x); }
__device__ __forceinline__ unsigned pk_bf16(float lo, float hi) { f32x2 v = {lo, hi}; bf16x2_t b = __builtin_convertvector(v, bf16x2_t); return __builtin_bit_cast(unsigned, b); }
__device__ __forceinline__ float bf_lo(unsigned w) { return __uint_as_float(w << 16); }
__device__ __forceinline__ float bf_hi(unsigned w) { return __uint_as_float(w & 0xffff0000u); }
__device__ __forceinline__ float sigmoidf_(float x) { return rcpf_(1.f + ex2(-x * LOG2E)); }
constexpr float GC0 = -1.5957691216057308f * LOG2E, GC1 = -1.5957691216057308f * 0.044715f * LOG2E;
__device__ __forceinline__ float gelu_e(float x) { return ex2(x * (GC0 + GC1 * (x * x))); }
__device__ __forceinline__ float gelu_tanh(float x) { return x * rcpf_(1.f + gelu_e(x)); }
__device__ __forceinline__ float siluf_(float x) { return x * sigmoidf_(x); }
__device__ __forceinline__ float xsum_fq(float v) {
    const auto a = __builtin_amdgcn_permlane16_swap(__float_as_uint(v), __float_as_uint(v), false, false);
    const float t = __uint_as_float(a[0]) + __uint_as_float(a[1]);
    const auto b = __builtin_amdgcn_permlane32_swap(__float_as_uint(t), __float_as_uint(t), false, false);
    return __uint_as_float(b[0]) + __uint_as_float(b[1]);
}
__device__ __forceinline__ float wave_sum(float v) {
#pragma unroll
    for (int o = 1; o < 64; o <<= 1) v += __shfl_xor(v, o);
    return v;
}

#ifndef KDUP
#define KDUP 1
#endif
namespace pg8 {
constexpr int BM = 256, BK = 64, HALF = 128, HTB = HALF * BK * 2, STAGE_BYTES = 8 * HTB, NXCD = 8, WGM = 8;
__host__ __device__ __forceinline__ int lds_byte(int r, int c) { const int st = (r >> 4) * 2 + (c >> 5), rr = r & 15, cc = c & 31, ob = rr * 64 + cc * 2; return st * 1024 + (ob ^ (((ob >> 9) & 1) << 5)); }
__host__ __device__ __forceinline__ void stage_rc(int b, int& R, int& C) { const int st = b / 1024, sb = b % 1024, swz = sb ^ (((sb >> 9) & 1) << 5); R = (st >> 1) * 16 + swz / 64; C = (st & 1) * 32 + (swz % 64) / 2; }
__host__ __device__ __forceinline__ int perm32(int rho) { const int n = rho >> 4, i = rho & 15; return 8 * (i >> 2) + 4 * n + (i & 3); }
struct Unit { int pm, pn; };
struct Gemm { const bf16_t* A; const bf16_t* Bt; int M, N, K; };
struct StaticOrder {
    int nM, nN, nwg, G, c, rep, dup;
    __device__ void init(int M_, int N_, int G_, int c_, int rep_ = 1, int dup_ = 1) { nM = M_ / BM; nN = N_ / BM; nwg = nM * nN; G = G_; c = c_; rep = rep_; dup = dup_; }
    __device__ bool next(int i, Unit& u) const {
        long L = (long)(i / dup) * G + c; if (L >= (long)nwg * rep) return false; L %= nwg;
        int wgid = (int)L; { const int q = nwg / NXCD, r = nwg % NXCD, xcd = wgid % NXCD, off = wgid / NXCD; wgid = (xcd < r ? xcd * (q + 1) : r * (q + 1) + (xcd - r) * q) + off; }
        const int nig = WGM * nN, gid = wgid / nig, fm = gid * WGM, gsz = (nM - fm) < WGM ? (nM - fm) : WGM;
        u.pm = fm + ((wgid % nig) % gsz); u.pn = (wgid % nig) / gsz; return true;
    }
};
struct PanelOrder {
    int nM, nN, G, c, rep;
    __device__ void init(int M_, int N_, int G_, int c_, int rep_ = 1) { nM = M_ / BM; nN = N_ / BM; G = G_; c = c_; rep = rep_; }
    __device__ bool next(int i, Unit& u) const { const int pm = c + G * (i / (nN * rep)); if (pm >= nM) return false; u.pm = pm; u.pn = i % nN; return true; }
};

template <class Epi, class Sched>
__device__ __forceinline__ void gemm_phase(LAS unsigned char* lds, const Gemm g, const Sched& S, const Epi& E) {
    const int tid = threadIdx.x, wid = __builtin_amdgcn_readfirstlane(tid >> 6), lane = tid & 63, wr = wid >> 2, wc = wid & 3, fr = lane & 15, fq = lane >> 4;
    const int K = g.K, nt = K / BK;
    unsigned voffA[2], voffB[2];
#pragma unroll
    for (int i = 0; i < 2; ++i) { int R, C; stage_rc(tid * 16 + i * 8192, R, C); const int Rb = Epi::PERM ? ((R & ~31) + perm32(R & 31)) : R;
        voffA[i] = (unsigned)(R * K + C) * 2u; voffB[i] = (unsigned)(Rb * K + C) * 2u; }
    const size_t kstep = (size_t)(BK * 2);
    const size_t hstep = (size_t)HALF * K * 2;
    const size_t tstep = 2 * hstep;
    const unsigned ldsw = (unsigned)wid * 1024u;
    const int aoff = lds_byte(wr * 64 + fr, fq * 8), boff = lds_byte(wc * 32 + fr, fq * 8);
#define PG8_SA(b, h) (((b) * 2 + (h)) * HTB)
#define PG8_SB(b, h) ((4 + (b) * 2 + (h)) * HTB)
#define PG8_STAGE(bufoff, gbase, voff) do { _Pragma("unroll") for (int _i = 0; _i < 2; ++_i) \
        __builtin_amdgcn_global_load_lds((const unsigned*)((const char*)(gbase) + (voff)[_i]), (LAS unsigned*)(lds + (bufoff) + ldsw + _i * 8192), 16, 0, 0); } while (0)
#define PG8_LDA(dst, b, h) do { _Pragma("unroll") for (int m = 0; m < 4; ++m) _Pragma("unroll") for (int k = 0; k < 2; ++k) dst[m][k] = *(const LAS bf16x8*)(lds + PG8_SA(b, h) + aoff + m * 2048 + k * 1024); } while (0)
#define PG8_LDB(dst, b, h) do { _Pragma("unroll") for (int n = 0; n < 2; ++n) _Pragma("unroll") for (int k = 0; k < 2; ++k) dst[n][k] = *(const LAS bf16x8*)(lds + PG8_SB(b, h) + boff + n * 2048 + k * 1024); } while (0)
#define PG8_MMA(ai, bj, At, Bt) do { __builtin_amdgcn_s_setprio(1); _Pragma("unroll") for (int m = 0; m < 4; ++m) _Pragma("unroll") for (int n = 0; n < 2; ++n) _Pragma("unroll") for (int k = 0; k < 2; ++k) \
        acc[ai][bj][m][n] = __builtin_amdgcn_mfma_f32_16x16x32_bf16(Bt[n][k], At[m][k], acc[ai][bj][m][n], 0, 0, 0); __builtin_amdgcn_s_setprio(0); } while (0)
#define PG8_WAIT_V(n) asm volatile("s_waitcnt vmcnt(" #n ")" ::: "memory")
#define PG8_WAIT_L(n) asm volatile("s_waitcnt lgkmcnt(" #n ")" ::: "memory")
#define PG8_BAR __builtin_amdgcn_s_barrier()
#define PG8_SCHED __builtin_amdgcn_sched_barrier(0)
#define PG8_KBODY(t) do { \
            const bool last = (t == nt - 2); \
            const char* a1 = cA + (size_t)(t + 1) * kstep; \
            const char* a2 = last ? nA : cA + (size_t)(t + 2) * kstep; const char* b2 = last ? nB : cB + (size_t)(t + 2) * kstep; \
            const char* a3 = a2 + kstep; const char* b3 = b2 + kstep; \
            PG8_LDB(B0, 0, 0); PG8_LDB(B1, 0, 1); PG8_SCHED; PG8_LDA(At, 0, 0); PG8_STAGE(PG8_SA(1, 1), a1 + hstep, voffA); \
            PG8_WAIT_V(8); PG8_WAIT_L(0); PG8_BAR; PG8_MMA(0, 0, At, B0); PG8_MMA(0, 1, At, B1); PG8_BAR; PG8_SCHED; \
            PG8_LDA(At, 0, 1); PG8_STAGE(PG8_SB(0, 0), b2, voffB); PG8_STAGE(PG8_SB(0, 1), b2 + hstep, voffB); PG8_STAGE(PG8_SA(0, 0), a2, voffA); \
            PG8_WAIT_V(8); PG8_WAIT_L(0); PG8_BAR; PG8_MMA(1, 0, At, B0); PG8_MMA(1, 1, At, B1); PG8_BAR; PG8_SCHED; \
            PG8_LDB(B0, 1, 0); PG8_LDB(B1, 1, 1); PG8_SCHED; PG8_LDA(At, 1, 0); PG8_STAGE(PG8_SA(0, 1), a2 + hstep, voffA); \
            PG8_WAIT_V(8); PG8_WAIT_L(0); PG8_BAR; PG8_MMA(0, 0, At, B0); PG8_MMA(0, 1, At, B1); PG8_BAR; PG8_SCHED; \
            PG8_LDA(At, 1, 1); PG8_STAGE(PG8_SB(1, 0), b3, voffB); PG8_STAGE(PG8_SB(1, 1), b3 + hstep, voffB); PG8_STAGE(PG8_SA(1, 0), a3, voffA); \
            PG8_WAIT_V(8); PG8_WAIT_L(0); PG8_BAR; PG8_MMA(1, 0, At, B0); PG8_MMA(1, 1, At, B1); PG8_BAR; PG8_SCHED; \
        } while (0)
    Unit cur, nxt; int ui = 0;
    if (!S.next(0, cur)) return;
    f32x4 acc[2][2][4][2];
#pragma unroll
    for (int a = 0; a < 2; ++a)
#pragma unroll
        for (int b = 0; b < 2; ++b)
#pragma unroll
            for (int m = 0; m < 4; ++m)
#pragma unroll
                for (int n = 0; n < 2; ++n) acc[a][b][m][n] = (f32x4){0.f, 0.f, 0.f, 0.f};
    bf16x8 At[4][2], B0[2][2], B1[2][2];
    const char* cA = (const char*)g.A + (size_t)cur.pm * tstep; const char* cB = (const char*)g.Bt + (size_t)cur.pn * tstep;
    PG8_STAGE(PG8_SB(0, 0), cB, voffB); PG8_STAGE(PG8_SB(0, 1), cB + hstep, voffB); PG8_STAGE(PG8_SA(0, 0), cA, voffA); PG8_STAGE(PG8_SA(0, 1), cA + hstep, voffA);
    if (wr == 1) PG8_BAR;
    PG8_WAIT_V(2); PG8_BAR;
    PG8_STAGE(PG8_SB(1, 0), cB + kstep, voffB); PG8_STAGE(PG8_SA(1, 0), cA + kstep, voffA); PG8_STAGE(PG8_SB(1, 1), cB + hstep + kstep, voffB);
    PG8_WAIT_V(6); PG8_BAR;
    for (;;) {
        const bool has_next = S.next(ui + 1, nxt);
        const char* nA = has_next ? (const char*)g.A + (size_t)nxt.pm * tstep : cA; const char* nB = has_next ? (const char*)g.Bt + (size_t)nxt.pn * tstep : cB;
        if constexpr (Epi::MIDHOOK) {
            for (int t = 0; t < nt / 2; t += 2) PG8_KBODY(t);
            E.mid(acc, cur, wr, wc, fr, fq);
            for (int t = nt / 2; t < nt; t += 2) PG8_KBODY(t);
        } else {
            for (int t = 0; t < nt; t += 2) PG8_KBODY(t);
        }
        if (wr == 0) PG8_BAR;
        if constexpr (Epi::FUSED) E.fused(acc, cur, wr, wc, fr, fq, lds + 131072, wid, lane); else { if (KDUP == 1 || !Epi::DUPSKIP || (ui % KDUP) == KDUP - 1) E(acc, cur, wr, wc, fr, fq); }
        if (!has_next) break;
#pragma unroll
        for (int a = 0; a < 2; ++a)
#pragma unroll
            for (int b = 0; b < 2; ++b)
#pragma unroll
                for (int m = 0; m < 4; ++m)
#pragma unroll
                    for (int n = 0; n < 2; ++n) acc[a][b][m][n] = (f32x4){0.f, 0.f, 0.f, 0.f};
        cur = nxt; cA = nA; cB = nB; ++ui;
        if (wr == 1) PG8_BAR;
    }
    PG8_WAIT_V(0);
    PG8_BAR;
#undef PG8_KBODY
#undef PG8_SA
#undef PG8_SB
#undef PG8_STAGE
#undef PG8_LDA
#undef PG8_LDB
#undef PG8_MMA
#undef PG8_WAIT_V
#undef PG8_WAIT_L
#undef PG8_BAR
#undef PG8_SCHED
}
}

__device__ __forceinline__ void st_out(u32x4* p, u32x4 w, bool keep) { if (keep) *p = w; else __builtin_nontemporal_store(w, p); }
struct EpiP1 {
    static constexpr bool PERM = true, MIDHOOK = false, FUSED = false, DUPSKIP = true;
    bf16_t *YAB, *VA, *KB, *VB, *ZB, *GA, *GB; float* ssv; LAS float* pss;
    template <int ACT> __device__ __forceinline__ void plain(const f32x4 (&acc)[2][2][4][2], bf16_t* base, int ldc, int row0, int colt, int slot, int fq, bool keep) const {
        const float qs = 0.08838834764831845f * LOG2E;
#pragma unroll
        for (int ai = 0; ai < 2; ++ai)
#pragma unroll
            for (int m = 0; m < 4; ++m) {
                const int row = row0 + ai * 128 + m * 16; float ss = 0.f;
#pragma unroll
                for (int bj = 0; bj < 2; ++bj) {
                    float o[8];
#pragma unroll
                    for (int n = 0; n < 2; ++n)
#pragma unroll
                        for (int j = 0; j < 4; ++j) { float v = acc[ai][bj][m][n][j];
                            if (ACT == 1) { v = gelu_tanh(v); ss += v * v; } else if (ACT == 2) v *= qs; else if (ACT == 3) v = v * rcpf_(1.f + ex2(-v * LOG2E));
                            o[n * 4 + j] = v; }
                    u32x4 w; w.x = pk_bf16(o[0], o[1]); w.y = pk_bf16(o[2], o[3]); w.z = pk_bf16(o[4], o[5]); w.w = pk_bf16(o[6], o[7]);
                    st_out((u32x4*)(base + (size_t)row * ldc + colt + bj * 128), w, keep);
                }
                if (ACT == 1) { ss = xsum_fq(ss); if (fq == 0) pss[((row & 255) << 2) + (slot & 3)] = ss; }
            }
        if (ACT == 1) {
            asm volatile("s_waitcnt lgkmcnt(0)" ::: "memory"); __builtin_amdgcn_s_barrier(); asm volatile("" ::: "memory");
            const int tid = threadIdx.x;
            if (tid < 256) { const f32x4 p = *((const LAS f32x4*)pss + tid); *(f32x4*)(ssv + (size_t)((row0 & ~255) + tid) * 16 + (slot & ~3)) = p; }
        }
    }
    __device__ __forceinline__ void operator()(const f32x4 (&acc)[2][2][4][2], const pg8::Unit& u, int wr, int wc, int fr, int fq) const {
        const int pn = u.pn; const int row0 = u.pm * 256 + wr * 64 + fr; const int cw = wc * 32 + 8 * fq;
        const bool keep = (u.pm & 31) >= 24;
        if (pn < 8) {
            const int col = pn * 128 + cw;
#pragma unroll
            for (int ai = 0; ai < 2; ++ai)
#pragma unroll
                for (int m = 0; m < 4; ++m) {
                    float o[8];
#pragma unroll
                    for (int n = 0; n < 2; ++n)
#pragma unroll
                        for (int j = 0; j < 4; ++j) { const float uu = acc[ai][0][m][n][j], zz = acc[ai][1][m][n][j]; o[n * 4 + j] = (uu * zz) * rcpf_((1.f + gelu_e(uu)) * (1.f + ex2(-zz * LOG2E))); }
                    u32x4 w; w.x = pk_bf16(o[0], o[1]); w.y = pk_bf16(o[2], o[3]); w.z = pk_bf16(o[4], o[5]); w.w = pk_bf16(o[6], o[7]);
                    st_out((u32x4*)(YAB + (size_t)(row0 + ai * 128 + m * 16) * 2048 + col), w, keep);
                }
        } else if (pn < 28) {
            const int seg = (pn - 8) >> 2; const int colt = ((pn - 8) & 3) * 256 + cw;
            if (seg == 0) plain<1>(acc, VA, 1024, row0, colt, (pn - 8) * 4 + wc, fq, keep);
            else if (seg == 1) plain<2>(acc, YAB + 1024, 2048, row0, colt, 0, fq, keep);
            else if (seg == 2) plain<0>(acc, KB, 1024, row0, colt, 0, fq, keep);
            else if (seg == 3) plain<0>(acc, VB, 1024, row0, colt, 0, fq, keep);
            else plain<3>(acc, ZB, 1024, row0, colt, 0, fq, keep);
        } else {
            const int col = (pn - 28) * 128 + cw;
#pragma unroll
            for (int ai = 0; ai < 2; ++ai)
#pragma unroll
                for (int m = 0; m < 4; ++m) {
                    float oa[8], ob[8];
#pragma unroll
                    for (int n = 0; n < 2; ++n)
#pragma unroll
                        for (int j = 0; j < 4; ++j) { const float ea = ex2(fminf(-acc[ai][0][m][n][j] * LOG2E, 60.f)), eb = ex2(fminf(-acc[ai][1][m][n][j] * LOG2E, 60.f));
                            oa[n * 4 + j] = (1.f + eb) * rcpf_(1.f + ea); ob[n * 4 + j] = rcpf_(1.f + eb); }
                    u32x4 w; w.x = pk_bf16(oa[0], oa[1]); w.y = pk_bf16(oa[2], oa[3]); w.z = pk_bf16(oa[4], oa[5]); w.w = pk_bf16(oa[6], oa[7]);
                    u32x4 x; x.x = pk_bf16(ob[0], ob[1]); x.y = pk_bf16(ob[2], ob[3]); x.z = pk_bf16(ob[4], ob[5]); x.w = pk_bf16(ob[6], ob[7]);
                    const size_t off = (size_t)(row0 + ai * 128 + m * 16) * 1024 + col;
                    __builtin_nontemporal_store(w, (u32x4*)(GA + off)); __builtin_nontemporal_store(x, (u32x4*)(GB + off));
                }
        }
    }
};
struct EpiP3 {
    static constexpr bool PERM = true, MIDHOOK = true, FUSED = false, DUPSKIP = false;
    const bf16_t *GA, *GB; bf16_t* MG;
    __device__ __forceinline__ void mid(f32x4 (&acc)[2][2][4][2], const pg8::Unit& u, int wr, int wc, int fr, int fq) const {
        const int row0 = u.pm * 256 + wr * 64 + fr; const int col0 = u.pn * 256 + wc * 32 + 8 * fq;
        unsigned base_off = (unsigned)row0 * 1024u + (unsigned)col0; asm volatile("" : "+v"(base_off));
#pragma unroll
        for (int ai = 0; ai < 2; ++ai) {
            u32x4 a[4][2];
#pragma unroll
            for (int m = 0; m < 4; ++m)
#pragma unroll
                for (int bj = 0; bj < 2; ++bj) a[m][bj] = *(const u32x4*)(GA + base_off + (unsigned)((ai * 128 + m * 16) * 1024 + bj * 128));
#pragma unroll
            for (int m = 0; m < 4; ++m)
#pragma unroll
                for (int bj = 0; bj < 2; ++bj) { const u32x4 r = a[m][bj];
                    acc[ai][bj][m][0] *= (f32x4){bf_lo(r.x), bf_hi(r.x), bf_lo(r.y), bf_hi(r.y)}; acc[ai][bj][m][1] *= (f32x4){bf_lo(r.z), bf_hi(r.z), bf_lo(r.w), bf_hi(r.w)}; }
            asm volatile("" : "+v"(acc[ai][0][0][0]), "+v"(acc[ai][0][0][1]), "+v"(acc[ai][1][0][0]), "+v"(acc[ai][1][0][1]), "+v"(acc[ai][0][1][0]), "+v"(acc[ai][0][1][1]), "+v"(acc[ai][1][1][0]), "+v"(acc[ai][1][1][1]),
                              "+v"(acc[ai][0][2][0]), "+v"(acc[ai][0][2][1]), "+v"(acc[ai][1][2][0]), "+v"(acc[ai][1][2][1]), "+v"(acc[ai][0][3][0]), "+v"(acc[ai][0][3][1]), "+v"(acc[ai][1][3][0]), "+v"(acc[ai][1][3][1]) :: "memory");
        }
    }
    __device__ __forceinline__ void operator()(const f32x4 (&acc)[2][2][4][2], const pg8::Unit& u, int wr, int wc, int fr, int fq) const {
        const int row0 = u.pm * 256 + wr * 64 + fr; const int col0 = u.pn * 256 + wc * 32 + 8 * fq;
        const bf16_t* GB2 = GB; asm volatile("" : "+s"(GB2));
        unsigned base_off = (unsigned)row0 * 1024u + (unsigned)col0; asm volatile("" : "+v"(base_off));
        u32x4 b[2][4][2];
#pragma unroll
        for (int ai = 0; ai < 2; ++ai)
#pragma unroll
            for (int m = 0; m < 4; ++m)
#pragma unroll
                for (int bj = 0; bj < 2; ++bj) b[ai][m][bj] = *(const u32x4*)(GB2 + base_off + (unsigned)((ai * 128 + m * 16) * 1024 + bj * 128));
#pragma unroll
        for (int ai = 0; ai < 2; ++ai)
#pragma unroll
            for (int m = 0; m < 4; ++m)
#pragma unroll
                for (int bj = 0; bj < 2; ++bj) {
                    const unsigned off = base_off + (unsigned)((ai * 128 + m * 16) * 1024 + bj * 128);
                    const u32x4 gb = b[ai][m][bj];
                    const f32x4 v0 = acc[ai][bj][m][0], v1 = acc[ai][bj][m][1];
                    u32x4 w; w.x = pk_bf16(v0[0] * bf_lo(gb.x), v0[1] * bf_hi(gb.x)); w.y = pk_bf16(v0[2] * bf_lo(gb.y), v0[3] * bf_hi(gb.y));
                    w.z = pk_bf16(v1[0] * bf_lo(gb.z), v1[1] * bf_hi(gb.z)); w.w = pk_bf16(v1[2] * bf_lo(gb.w), v1[3] * bf_hi(gb.w));
                    __builtin_nontemporal_store(w, (u32x4*)(MG + off));
                }
        asm volatile("" ::: "memory");
    }
};
struct EpiP4 {
    static constexpr bool PERM = false, MIDHOOK = false, FUSED = true, DUPSKIP = false;
    const float* x; float* out; const float* gain; float* slots; unsigned* cnt;
    __device__ __forceinline__ void fused(f32x4 (&acc)[2][2][4][2], const pg8::Unit& u, int wr, int wc, int fr, int fq, LAS unsigned char* ldsm, int wid, int lane) const {
        LAS float* P = (LAS float*)(ldsm + 1024);
        LAS float* S = (LAS float*)(ldsm + 1024 + 4096);
        const int row0 = u.pm * 256 + wr * 64 + fr; const int col0 = u.pn * 256 + wc * 32 + 4 * fq;
#pragma unroll
        for (int ai = 0; ai < 2; ++ai)
#pragma unroll
            for (int m = 0; m < 4; ++m) {
                const int row = row0 + ai * 128 + m * 16; float ss = 0.f;
#pragma unroll
                for (int bj = 0; bj < 2; ++bj)
#pragma unroll
                    for (int n = 0; n < 2; ++n) {
                        const f32x4 v = *(const f32x4*)(x + (size_t)row * 1024 + col0 + bj * 128 + n * 16) + acc[ai][bj][m][n];
                        ss += (v[0] * v[0] + v[1] * v[1]) + (v[2] * v[2] + v[3] * v[3]);
                        acc[ai][bj][m][n] = v;
                    }
                ss = xsum_fq(ss);
                if (fq == 0) P[(ai * 128 + wr * 64 + m * 16 + fr) * 4 + wc] = ss;
                if (m & 1) asm volatile("" : "+v"(acc[ai][0][m][0]), "+v"(acc[ai][0][m][1]), "+v"(acc[ai][1][m][0]), "+v"(acc[ai][1][m][1]), "+v"(acc[ai][0][m - 1][0]), "+v"(acc[ai][0][m - 1][1]), "+v"(acc[ai][1][m - 1][0]), "+v"(acc[ai][1][m - 1][1]) :: "memory");
            }
        asm volatile("s_waitcnt lgkmcnt(0)" ::: "memory"); __builtin_amdgcn_s_barrier(); asm volatile("" ::: "memory");
        const int tid = wid * 64 + lane;
        unsigned* pc = cnt + 64 * u.pm;
        if (tid < 256) {
            const f32x4 p = *(const LAS f32x4*)(P + tid * 4);
            const float tot = (p[0] + p[1]) + (p[2] + p[3]);
            __hip_atomic_store(slots + ((size_t)(u.pm * 256 + tid) * 4 + u.pn), tot, __ATOMIC_RELAXED, __HIP_MEMORY_SCOPE_AGENT);
            asm volatile("s_waitcnt vmcnt(0)" ::: "memory");
            if (lane == 0) __hip_atomic_fetch_add(pc, 1u, __ATOMIC_RELAXED, __HIP_MEMORY_SCOPE_AGENT);
        }
        if (wid == 0) {
            unsigned spins = 0;
            while ((unsigned)__builtin_amdgcn_readfirstlane(__hip_atomic_load(pc, __ATOMIC_RELAXED, __HIP_MEMORY_SCOPE_AGENT)) < 16u) { __builtin_amdgcn_s_sleep(2); if (++spins > (1u << 24)) break; }
            __builtin_amdgcn_fence(__ATOMIC_ACQUIRE, "agent");
        }
        asm volatile("s_waitcnt vmcnt(0) lgkmcnt(0)" ::: "memory"); __builtin_amdgcn_s_barrier(); asm volatile("" ::: "memory");
        if (tid < 256) {
            const float* sl = slots + (size_t)(u.pm * 256 + tid) * 4;
            const float a0 = __hip_atomic_load(sl + 0, __ATOMIC_RELAXED, __HIP_MEMORY_SCOPE_AGENT), a1 = __hip_atomic_load(sl + 1, __ATOMIC_RELAXED, __HIP_MEMORY_SCOPE_AGENT);
            const float a2 = __hip_atomic_load(sl + 2, __ATOMIC_RELAXED, __HIP_MEMORY_SCOPE_AGENT), a3 = __hip_atomic_load(sl + 3, __ATOMIC_RELAXED, __HIP_MEMORY_SCOPE_AGENT);
            S[tid] = 1.0f / sqrtf(((a0 + a1) + (a2 + a3)) * (1.0f / 1024.0f) + EPS);
        }
        asm volatile("s_waitcnt vmcnt(0) lgkmcnt(0)" ::: "memory"); __builtin_amdgcn_s_barrier(); asm volatile("" ::: "memory");
        f32x4 gn[2][2];
#pragma unroll
        for (int bj = 0; bj < 2; ++bj)
#pragma unroll
            for (int n = 0; n < 2; ++n) gn[bj][n] = *(const f32x4*)(gain + col0 + bj * 128 + n * 16);
#pragma unroll
        for (int ai = 0; ai < 2; ++ai)
#pragma unroll
            for (int m = 0; m < 4; ++m) {
                const int rl = ai * 128 + wr * 64 + m * 16 + fr; const float r = S[rl]; const size_t ro = (size_t)(u.pm * 256 + rl) * 1024 + col0;
#pragma unroll
                for (int bj = 0; bj < 2; ++bj)
#pragma unroll
                    for (int n = 0; n < 2; ++n) __builtin_nontemporal_store(acc[ai][bj][m][n] * r * gn[bj][n], (f32x4*)(out + ro + bj * 128 + n * 16));
            }
    }
};

__device__ __forceinline__ void transpose_item(const float* W, int N, bf16_t* WT, int ldk, int kofs, int dst_row0, LAS float* scr, int k0, int n0, int lane) {
#pragma unroll 8
    for (int i = 0; i < 32; ++i) { const int kk = 2 * i + (lane >> 5); scr[kk * 33 + (lane & 31)] = W[(size_t)(k0 + kk) * N + n0 + (lane & 31)]; }
    asm volatile("s_waitcnt lgkmcnt(0)" ::: "memory");
    const int c = lane & 7;
#pragma unroll
    for (int j = 0; j < 4; ++j) { const int n = (lane >> 3) + 8 * j; const LAS float* s = scr + (8 * c) * 33 + n;
        u32x4 o; o.x = pk_bf16(s[0 * 33], s[1 * 33]); o.y = pk_bf16(s[2 * 33], s[3 * 33]); o.z = pk_bf16(s[4 * 33], s[5 * 33]); o.w = pk_bf16(s[6 * 33], s[7 * 33]);
        *(u32x4*)(WT + (size_t)(dst_row0 + n) * ldk + kofs + k0 + 8 * c) = o; }
    asm volatile("s_waitcnt lgkmcnt(0)" ::: "memory");
}
__device__ __forceinline__ int win_dst_row(int n0) {
    const int seg = n0 >> 10, within = n0 & 1023, j = within >> 7, i = within & 127;
    if (seg == 0) return 256 * j + i;
    if (seg == 2) return 256 * j + 128 + i;
    if (seg == 1) return 2048 + within;
    if (seg <= 6) return seg * 1024 + within;
    if (seg == 7) return 7168 + 256 * j + i;
    return 7168 + 256 * j + 128 + i;
}

constexpr int ATT_KBUF = 16384, ATT_VBUF = 20480, ATT_K0 = 0, ATT_V0 = 2 * ATT_KBUF, ATT_FLAGS = ATT_V0 + 2 * ATT_VBUF;
#ifndef SB_EARLY_EXIT
#define SB_EARLY_EXIT 1
#endif
__device__ __forceinline__ s16x4 tr16(const LAS unsigned char* p) { return __builtin_bit_cast(s16x4, __builtin_amdgcn_ds_read_tr16_b64_v4i16((LAS s16x4*)p)); }

__device__ __forceinline__ void att_tile(const LAS unsigned char* Kb, const LAS unsigned char* Vb, int t, int qw0, int myq, int hi, int kperm, unsigned vlane,
                                         const bf16x8 (&qf)[8], f32x16 (&o)[4], float& carry, bool walive) {
#pragma unroll
        for (int sbi = 0; sbi < 2; ++sbi) {
            const int sb = 1 - sbi; const int kb = 64 * t + 32 * sb;
            if (kb < qw0 + 31 && walive) {
                const int krow = 32 * sb + kperm; const int swz = (krow & 7) + 8 * ((krow >> 4) & 1);
                const LAS unsigned char* kp = Kb + krow * 256;
                f32x16 s;
#pragma unroll
                for (int r = 0; r < 16; ++r) s[r] = 0.f;
#pragma unroll
                for (int kk = 0; kk < 8; ++kk) { const bf16x8 a = *(const LAS bf16x8*)(kp + (((2 * kk + hi) ^ swz) * 16)); s = __builtin_amdgcn_mfma_f32_32x32x16_bf16(a, qf[kk], s, 0, 0, 0); }
                const bool needmask = (kb + 31 >= qw0);
                const int key0 = kb + 16 * hi;
                float wl[16]; float Ploc = 1.f;
                if (needmask) {
#pragma unroll
                    for (int r = 15; r >= 0; --r) {
                        float beta = rcpf_(1.f + ex2(-s[r]));
                        if (key0 + r >= myq) beta = 0.f;
                        wl[r] = beta * Ploc; Ploc -= wl[r];
                    }
                } else {
#pragma unroll
                    for (int r = 15; r >= 0; --r) { wl[r] = Ploc * rcpf_(1.f + ex2(-s[r])); Ploc -= wl[r]; }
                }
                const float Tother = __shfl_xor(Ploc, 32);
                const float cstart = carry * (hi == 0 ? Tother : 1.f);
                carry = carry * (Ploc * Tother);
                u32x4 w0, w1;
                w0.x = pk_bf16(wl[0] * cstart, wl[1] * cstart); w0.y = pk_bf16(wl[2] * cstart, wl[3] * cstart); w0.z = pk_bf16(wl[4] * cstart, wl[5] * cstart); w0.w = pk_bf16(wl[6] * cstart, wl[7] * cstart);
                w1.x = pk_bf16(wl[8] * cstart, wl[9] * cstart); w1.y = pk_bf16(wl[10] * cstart, wl[11] * cstart); w1.z = pk_bf16(wl[12] * cstart, wl[13] * cstart); w1.w = pk_bf16(wl[14] * cstart, wl[15] * cstart);
                const bf16x8 wb0 = __builtin_bit_cast(bf16x8, w0), wb1 = __builtin_bit_cast(bf16x8, w1);
                const LAS unsigned char* vp = Vb + (32 * sb) * 320 + vlane;
#pragma unroll
                for (int dt = 0; dt < 4; ++dt) {
                    const s16x4 a0 = tr16(vp + dt * 64), a1 = tr16(vp + 4 * 320 + dt * 64);
                    const s16x4 c0 = tr16(vp + 8 * 320 + dt * 64), c1 = tr16(vp + 12 * 320 + dt * 64);
                    const bf16x8 fa = __builtin_shufflevector(a0, a1, 0, 1, 2, 3, 4, 5, 6, 7), fc = __builtin_shufflevector(c0, c1, 0, 1, 2, 3, 4, 5, 6, 7);
                    o[dt] = __builtin_amdgcn_mfma_f32_32x32x16_bf16(fa, wb0, o[dt], 0, 0, 0);
                    o[dt] = __builtin_amdgcn_mfma_f32_32x32x16_bf16(fc, wb1, o[dt], 0, 0, 0);
                }
            }
        }
}

__device__ __forceinline__ void attn_unit(LAS unsigned char* lds, int b, int h, int qt, bf16_t* YAB, const bf16_t* KB, const bf16_t* VB, const bf16_t* ZB, bool do_store) {
    const int tid = threadIdx.x, lane = tid & 63, wid = __builtin_amdgcn_readfirstlane(tid >> 6), r32 = lane & 31, hi = lane >> 5;
    const int tok0 = b * SEQ, q0 = qt * 256, qw0 = q0 + 32 * wid, myq = qw0 + r32;
    bf16x8 qf[8];
    { const bf16_t* qp = YAB + (size_t)(tok0 + myq) * 2048 + 1024 + h * HD + 8 * hi;
#pragma unroll
      for (int kk = 0; kk < 8; ++kk) qf[kk] = *(const bf16x8*)(qp + 16 * kk); }
    const int skey0 = tid >> 4, sc0 = tid & 15; const int sswz = (skey0 & 7) + 8 * ((skey0 >> 4) & 1);
    const unsigned kdst0 = (unsigned)(skey0 * 256 + ((sc0 ^ sswz) * 16)), vdst0 = (unsigned)(skey0 * 320 + sc0 * 16);
    const bf16_t* kg = KB + (size_t)tok0 * 1024 + h * HD; const bf16_t* vg = VB + (size_t)tok0 * 1024 + h * HD;
    u32x4 kA[2], vA[2], kB[2], vB[2];
    const int T0 = qt * 4 + 3;
#define ATT_LOAD(KR, VR, tile) do { _Pragma("unroll") for (int i = 0; i < 2; ++i) { const size_t go = (size_t)(64 * (tile) + skey0 + 32 * i) * 1024 + 8 * sc0; KR[i] = *(const u32x4*)(kg + go); VR[i] = *(const u32x4*)(vg + go); } } while (0)
#define ATT_WRITE(KR, VR, buf) do { _Pragma("unroll") for (int i = 0; i < 2; ++i) { *(LAS u32x4*)(lds + ATT_K0 + (buf) * ATT_KBUF + kdst0 + 8192 * i) = KR[i]; *(LAS u32x4*)(lds + ATT_V0 + (buf) * ATT_VBUF + vdst0 + 10240 * i) = VR[i]; } } while (0)
    ATT_LOAD(kA, vA, T0); ATT_LOAD(kB, vB, T0 - 1);
    ATT_WRITE(kA, vA, 0);
    __syncthreads();
    f32x16 o[4];
#pragma unroll
    for (int d = 0; d < 4; ++d)
#pragma unroll
        for (int r = 0; r < 16; ++r) o[d][r] = 0.f;
    float carry = 1.f; bool walive = true;
    const int kperm = 16 * ((r32 >> 2) & 1) + (r32 & 3) + 4 * (r32 >> 3);
    const int i16 = lane & 15, qd = i16 >> 2, pp = i16 & 3, blk = (lane >> 4) & 1;
    const unsigned vlane = (unsigned)((16 * hi + qd) * 320 + (16 * blk + 4 * pp) * 2);
    int cur = 0; int it = 0; int t = T0;
#define ATT_STEP(KF, VF, KH, VH) { \
        if (t >= 2) ATT_LOAD(KF, VF, t - 2); \
        att_tile(lds + ATT_K0 + cur * ATT_KBUF, lds + ATT_V0 + cur * ATT_VBUF, t, qw0, myq, hi, kperm, vlane, qf, o, carry, walive); \
        if (t >= 1) ATT_WRITE(KH, VH, cur ^ 1); \
        walive = __any(carry > 0x1p-134f);     \
        if (lane == 0) ((LAS unsigned*)(lds + ATT_FLAGS))[(it & 1) * 8 + wid] = walive ? 1u : 0u; \
        __syncthreads(); \
        { const LAS unsigned* fl = (const LAS unsigned*)(lds + ATT_FLAGS) + (it & 1) * 8; \
          const unsigned any = fl[0] | fl[1] | fl[2] | fl[3] | fl[4] | fl[5] | fl[6] | fl[7]; \
          if (any == 0u || t == 0) break; }     \
        --t; cur ^= 1; ++it; }
    for (;;) {
        ATT_STEP(kA, vA, kB, vB)
        ATT_STEP(kB, vB, kA, vA)
    }
#undef ATT_STEP
#undef ATT_LOAD
#undef ATT_WRITE
    { const bf16_t* zp = ZB + (size_t)(tok0 + myq) * 1024 + h * HD + 8 * hi; bf16_t* op = YAB + (size_t)(tok0 + myq) * 2048 + 1024 + h * HD + 8 * hi;
#pragma unroll
      for (int dt = 0; dt < 4; ++dt)
#pragma unroll
          for (int p = 0; p < 2; ++p) {
              const u32x4 z = *(const u32x4*)(zp + 32 * dt + 16 * p);
              float v[8];
#pragma unroll
              for (int j = 0; j < 4; ++j) {
                  const auto rr = __builtin_amdgcn_permlane32_swap(__float_as_uint(o[dt][8 * p + j]), __float_as_uint(o[dt][8 * p + 4 + j]), false, false);
                  v[j] = __uint_as_float(rr[0]); v[4 + j] = __uint_as_float(rr[1]);
              }
              u32x4 w; w.x = pk_bf16(v[0] * bf_lo(z.x), v[1] * bf_hi(z.x)); w.y = pk_bf16(v[2] * bf_lo(z.y), v[3] * bf_hi(z.y));
              w.z = pk_bf16(v[4] * bf_lo(z.z), v[5] * bf_hi(z.z)); w.w = pk_bf16(v[6] * bf_lo(z.w), v[7] * bf_hi(z.w));
              if (do_store) *(u32x4*)(op + 32 * dt + 16 * p) = w;
          } }
}

constexpr int GM_V = 0, GM_RSTD = 40960, GM_STG = 41472, GM_STGP = 132;
__device__ __forceinline__ void gmlp_phase(LAS unsigned char* lds, int cu, int G, bf16_t* YAB, const bf16_t* VA, const float* ssv, const float* w_s, const float* b_s, const float* norm_v) {
    const int tid = threadIdx.x, lane = tid & 63, wid = __builtin_amdgcn_readfirstlane(tid >> 6), r32 = lane & 31, hi = lane >> 5;
    const int ttile = wid & 3, chalf = wid >> 2; const int t = 32 * ttile + r32;
    const bool fixg = (G & 7) == 0;
    const int nun = fixg ? (512 - (cu >> 3) + (G >> 3) - 1) / (G >> 3) : (4096 - cu + G - 1) / G;
    if (nun <= 0) return;
#define GM_UNIT(i, p_, g_) do { if (fixg) { p_ = (cu >> 3) + (G >> 3) * (i); g_ = cu & 7; } else { const int v_ = cu + G * (i); p_ = v_ >> 3; g_ = v_ & 7; } } while (0)
    u32x4 vld[4], uzC[4]; f32x4 ssl[4];
    f32x4 wa[8], wb[8], bs[4]; float nv[2]; int gcur = -1;
#define GM_LOADS(p_, g_) do { const int tok_ = ((p_) >> 4) * SEQ + ((p_) & 15) * CHUNK; \
        _Pragma("unroll") for (int i = 0; i < 4; ++i) { const int id = tid + 512 * i, s_ = id >> 4, c_ = id & 15; \
            vld[i] = *(const u32x4*)(VA + (size_t)(tok_ + s_) * 1024 + (g_) * 128 + 8 * c_); } \
        if (tid < 128) { const f32x4* p4 = (const f32x4*)(ssv + (size_t)(tok_ + tid) * 16); ssl[0] = p4[0]; ssl[1] = p4[1]; ssl[2] = p4[2]; ssl[3] = p4[3]; } } while (0)
    int p, g; GM_UNIT(0, p, g);
    GM_LOADS(p, g);
    const int i16 = lane & 15, qd = i16 >> 2, pp = i16 & 3, blk = (lane >> 4) & 1;
    const LAS unsigned char* vp = lds + GM_V + (8 * hi + qd) * 320 + (64 * chalf + 16 * blk + 4 * pp) * 2;
    const LAS float* rs = (const LAS float*)(lds + GM_RSTD);
    const int nks = 2 * (ttile + 1);
    for (int iu = 0; iu < nun; ++iu) {
        const int tok0 = (p >> 4) * SEQ + (p & 15) * CHUNK;
        if (g != gcur) {
            const float* wrow = w_s + ((size_t)g * 128 + t) * 128 + 8 * hi;
#pragma unroll
            for (int kk = 0; kk < 8; ++kk) { wa[kk] = *(const f32x4*)(wrow + 16 * kk); wb[kk] = *(const f32x4*)(wrow + 16 * kk + 4); }
#pragma unroll
            for (int ct = 0; ct < 2; ++ct) nv[ct] = norm_v[g * 128 + 64 * chalf + 32 * ct + r32];
#pragma unroll
            for (int g4 = 0; g4 < 4; ++g4) bs[g4] = *(const f32x4*)(b_s + g * 128 + 32 * ttile + 8 * g4 + 4 * hi);
            gcur = g;
        }
#pragma unroll
        for (int i = 0; i < 4; ++i) { const int id = tid + 512 * i, s_ = id >> 4, c_ = id & 15; *(LAS u32x4*)(lds + GM_V + s_ * 320 + c_ * 16) = vld[i]; }
        if (tid < 128) {
            const float sum = ((ssl[0][0] + ssl[0][1]) + (ssl[0][2] + ssl[0][3])) + ((ssl[1][0] + ssl[1][1]) + (ssl[1][2] + ssl[1][3])) + ((ssl[2][0] + ssl[2][1]) + (ssl[2][2] + ssl[2][3])) + ((ssl[3][0] + ssl[3][1]) + (ssl[3][2] + ssl[3][3]));
            ((LAS float*)(lds + GM_RSTD))[tid] = 1.0f / sqrtf(sum * (1.0f / 1024.0f) + EPS); }
        __syncthreads();
        int pn_ = p, gn_ = g;
#pragma unroll
        for (int i = 0; i < 4; ++i) { const int id = tid + 512 * i, s_ = id >> 4, c_ = id & 15; uzC[i] = *(const u32x4*)(YAB + (size_t)(tok0 + s_) * 2048 + g * 128 + 8 * c_); }
        if (iu + 1 < nun) { GM_UNIT(iu + 1, pn_, gn_); GM_LOADS(pn_, gn_); }
        f32x16 acc[2];
#pragma unroll
        for (int ct = 0; ct < 2; ++ct)
#pragma unroll
            for (int r = 0; r < 16; ++r) acc[ct][r] = 0.f;
#pragma unroll
        for (int kk = 0; kk < 8; ++kk) {
            if (kk < nks) {
                const int s0 = 16 * kk + 8 * hi;
                const f32x4 ra = *(const LAS f32x4*)(rs + s0), rb = *(const LAS f32x4*)(rs + s0 + 4);
                float a8[8];
#pragma unroll
                for (int j = 0; j < 4; ++j) { a8[j] = (s0 + j <= t) ? wa[kk][j] * ra[j] : 0.f; a8[4 + j] = (s0 + 4 + j <= t) ? wb[kk][j] * rb[j] : 0.f; }
                u32x4 aw; aw.x = pk_bf16(a8[0], a8[1]); aw.y = pk_bf16(a8[2], a8[3]); aw.z = pk_bf16(a8[4], a8[5]); aw.w = pk_bf16(a8[6], a8[7]);
                const bf16x8 af = __builtin_bit_cast(bf16x8, aw);
#pragma unroll
                for (int ct = 0; ct < 2; ++ct) {
                    const s16x4 lo = tr16(vp + (16 * kk) * 320 + ct * 64), hi4 = tr16(vp + (16 * kk + 4) * 320 + ct * 64);
                    const bf16x8 bfr = __builtin_shufflevector(lo, hi4, 0, 1, 2, 3, 4, 5, 6, 7);
                    acc[ct] = __builtin_amdgcn_mfma_f32_32x32x16_bf16(af, bfr, acc[ct], 0, 0, 0);
                }
            }
        }
        { LAS float* stg = (LAS float*)(lds + GM_STG);
#pragma unroll
          for (int ct = 0; ct < 2; ++ct) { const int c = 64 * chalf + 32 * ct + r32;
#pragma unroll
              for (int g4 = 0; g4 < 4; ++g4) { const int tb = 32 * ttile + 8 * g4 + 4 * hi;
#pragma unroll
                  for (int j = 0; j < 4; ++j) stg[(tb + j) * GM_STGP + c] = acc[ct][4 * g4 + j] * nv[ct] + bs[g4][j]; } } }
        __syncthreads();
#pragma unroll
        for (int i = 0; i < 4; ++i) { const int id = tid + 512 * i, tt = id >> 4, cc = id & 15;
            const LAS float* sp = (const LAS float*)(lds + GM_STG) + tt * GM_STGP + 8 * cc; const f32x4 m0 = *(const LAS f32x4*)sp, m1 = *(const LAS f32x4*)(sp + 4);
            bf16_t* gp = YAB + (size_t)(tok0 + tt) * 2048 + g * 128 + 8 * cc; const u32x4 uz = uzC[i];
            u32x4 w; w.x = pk_bf16(bf_lo(uz.x) * m0[0], bf_hi(uz.x) * m0[1]); w.y = pk_bf16(bf_lo(uz.y) * m0[2], bf_hi(uz.y) * m0[3]);
            w.z = pk_bf16(bf_lo(uz.z) * m1[0], bf_hi(uz.z) * m1[1]); w.w = pk_bf16(bf_lo(uz.w) * m1[2], bf_hi(uz.w) * m1[3]);
            *(u32x4*)gp = w; }
        __syncthreads();
        p = pn_; g = gn_;
    }
#undef GM_UNIT
#undef GM_LOADS
}


#define XB_TMO      128
#define XB_XCNT(j)  (256  + 64 * (j))
#define XB_XSUB(j)  (1280 + 64 * (j))
#define XB_XGEN(j)  (2304 + 64 * (j))
#define XB_TOP      3328
#define XB_TOPGEN   3392
#define XCD_BAR_WORDS 3456
#define XB_SPIN_CAP (1u << 18)
__device__ __forceinline__ unsigned xb_ld(unsigned* p)              { return __hip_atomic_load(p, __ATOMIC_RELAXED, __HIP_MEMORY_SCOPE_AGENT); }
__device__ __forceinline__ unsigned xb_add(unsigned* p, unsigned v) { return __hip_atomic_fetch_add(p, v, __ATOMIC_RELAXED, __HIP_MEMORY_SCOPE_AGENT); }
__device__ __forceinline__ unsigned xb_xcc_id() { return (unsigned)__builtin_amdgcn_s_getreg((3 << 11) | 20) & 0xFu; }
#define XB_SPIN(cond, bar) do { unsigned _sp = 0; while (cond) { __builtin_amdgcn_s_sleep(1); \
    if ((++_sp & 255u) == 0u) { if (xb_ld(&(bar)[XB_TMO])) break; if (_sp > XB_SPIN_CAP) { atomicAdd(&(bar)[XB_TMO], 1u); break; } } } } while (0)
struct XcdBarrier { unsigned* bar; unsigned x; volatile LAS unsigned* st; };
__device__ __forceinline__ XcdBarrier xcd_barrier_post(unsigned* bar, volatile LAS unsigned* st) {
    XcdBarrier b; b.bar = bar; b.x = xb_xcc_id(); b.st = st;
    if (threadIdx.x == 0) (void)xb_add(&bar[XB_XCNT(b.x)], 1u);
    return b;
}
__device__ __forceinline__ void xcd_barrier_complete(unsigned* bar, unsigned x, unsigned& nloc, unsigned& nx) {
    const unsigned G = gridDim.x * gridDim.y * gridDim.z;
    unsigned sum, cnt, mine, sp = 0u;
    for (;;) {
        sum = 0u; cnt = 0u; mine = 0u;
#pragma unroll
        for (unsigned j = 0; j < 16; ++j) { const unsigned c = xb_ld(&bar[XB_XCNT(j)]); sum += c; cnt += (c > 0u) ? 1u : 0u; mine = (j == x) ? c : mine; }
        if (sum == G) break;
        __builtin_amdgcn_s_sleep(1);
        if ((++sp & 255u) == 0u) { if (xb_ld(&bar[XB_TMO])) break; if (sp > XB_SPIN_CAP) { atomicAdd(&bar[XB_TMO], 1u); break; } }
    }
    nloc = mine > 0u ? mine : 1u; nx = cnt > 0u ? cnt : 1u;
}
__device__ __forceinline__ void xcd_barrier(unsigned* bar_, volatile LAS unsigned* st_) {
    asm volatile("s_waitcnt vmcnt(0)" ::: "memory");
    __syncthreads();
    if (threadIdx.x == 0) {
        XcdBarrier b; b.bar = bar_; b.x = xb_xcc_id(); b.st = st_;
        unsigned* bar = b.bar;
        __builtin_amdgcn_s_waitcnt(0);
        unsigned nloc = b.st[0], nx = b.st[1];
        if (nloc == 0u) { xcd_barrier_complete(bar, b.x, nloc, nx); b.st[0] = nloc; b.st[1] = nx; }
        const unsigned old = xb_add(&bar[XB_XSUB(b.x)], 1u);
        const unsigned gen = old / nloc;
        if (old + 1u == (gen + 1u) * nloc) {
            __builtin_amdgcn_fence(__ATOMIC_RELEASE, "agent");
            asm volatile("s_waitcnt vmcnt(0)" ::: "memory");
            const unsigned og = xb_add(&bar[XB_TOP], 1u);
            const unsigned tg = og / nx;
            if (og + 1u == (tg + 1u) * nx) xb_add(&bar[XB_TOPGEN], 1u);
            else XB_SPIN(xb_ld(&bar[XB_TOPGEN]) == tg, bar);
            __builtin_amdgcn_fence(__ATOMIC_ACQUIRE, "agent");
            xb_add(&bar[XB_XGEN(b.x)], 1u);
            asm volatile("s_waitcnt vmcnt(0)" ::: "memory");
        } else {
            XB_SPIN(xb_ld(&bar[XB_XGEN(b.x)]) == gen, bar);
            __builtin_amdgcn_fence(__ATOMIC_ACQUIRE, "agent");
            asm volatile("s_waitcnt vmcnt(0)" ::: "memory");
        }
    }
    __syncthreads();
}

struct Args { const float* in[10]; float* out; unsigned char* ws; };
#ifndef PHM
#define PHM 31
#endif
#ifndef ATT_REP
#define ATT_REP 1
#endif
#ifndef GM_REP
#define GM_REP 1
#endif
#ifndef REP0
#define REP0 1
#endif
#ifndef REP1
#define REP1 1
#endif
#ifndef REP3
#define REP3 1
#endif
#ifndef REP4
#define REP4 1
#endif
#ifndef P2M
#define P2M 3
#endif
constexpr int N_ATT = BATCH * NH * (SEQ / 256), N_GM = BATCH * (SEQ / CHUNK) * NG;

__global__ void __launch_bounds__(512, 2) fwd_megakernel(Args args) {
    extern __shared__ __attribute__((aligned(16))) unsigned char lds_raw[];
    LAS unsigned char* lds = (LAS unsigned char*)lds_raw;
    cg::grid_group grid = cg::this_grid();
    const int tid = threadIdx.x, lane = tid & 63, wave = __builtin_amdgcn_readfirstlane(tid >> 6);
    const int G = gridDim.x;
    const float* x = args.in[0]; const float* norm_in = args.in[1]; const float* w_in = args.in[2]; const float* norm_v = args.in[3]; const float* w_s = args.in[4];
    const float* b_s = args.in[5]; const float* w_o_gmlp = args.in[6]; const float* w_o_sb = args.in[7]; const float* w_out = args.in[8]; const float* norm_final = args.in[9];
    unsigned char* ws = args.ws; float* out = args.out;
    unsigned* ctl = (unsigned*)(ws + WS_CTL);
    volatile LAS unsigned* xst = (volatile LAS unsigned*)(lds + LDS_MISC + 64);
    if (tid < 2) xst[tid] = 0u;
    __syncthreads();
    for (unsigned w = blockIdx.x * 512u + tid; w < CTL_BYTES / 4; w += gridDim.x * 512u) ctl[w] = 0u;
    bf16_t* WIN = (bf16_t*)(ws + WS_WIN); bf16_t* WCAT = (bf16_t*)(ws + WS_WCAT); bf16_t* WOUT = (bf16_t*)(ws + WS_WOUT);
    float* ssv = (float*)(ws + WS_SSV); float* ssf = (float*)(ws + WS_SSF);
    bf16_t* YAB = (bf16_t*)(ws + WS_YAB); bf16_t* VA = (bf16_t*)(ws + WS_VA); bf16_t* VB = (bf16_t*)(ws + WS_VB); bf16_t* ZB = (bf16_t*)(ws + WS_ZB);
    bf16_t* GA = (bf16_t*)(ws + WS_GA); bf16_t* GB = (bf16_t*)(ws + WS_GB); bf16_t* MG = VA;
    bf16_t* XN = (bf16_t*)out; bf16_t* KB = (bf16_t*)out + (size_t)M * 1024;

    for (int rep_ = 0; rep_ < REP0; ++rep_) {
        LAS float* scr = (LAS float*)(lds + wave * 16384);
        const int gw = blockIdx.x * 8 + wave, NGW = G * 8;
        constexpr int I_IN = 16 * (NIN / 32), I_SQ = 16 * 32;
        for (int it = gw; it < I_IN + 3 * I_SQ; it += NGW) {
            int r = it;
            if (r < I_IN) { const int kb = r / (NIN / 32), nb = r % (NIN / 32); transpose_item(w_in, NIN, WIN, 1024, 0, win_dst_row(32 * nb), scr, 64 * kb, 32 * nb, lane); continue; }
            r -= I_IN; const int which = r / I_SQ; r -= which * I_SQ; const int kb = r / 32, nb = r % 32;
            if (which == 0) transpose_item(w_o_gmlp, 1024, WCAT, 2048, 0, 32 * nb, scr, 64 * kb, 32 * nb, lane);
            else if (which == 1) transpose_item(w_o_sb, 1024, WCAT, 2048, 1024, 32 * nb, scr, 64 * kb, 32 * nb, lane);
            else transpose_item(w_out, 1024, WOUT, 1024, 0, 32 * nb, scr, 64 * kb, 32 * nb, lane);
        }
        f32x4 gn[4];
#pragma unroll
        for (int j = 0; j < 4; ++j) gn[j] = *((const f32x4*)norm_in + lane + 64 * j);
        for (int m = gw; m < M; m += 4 * NGW) {
            f32x4 v[4][4]; float sq[4];
#pragma unroll
            for (int q = 0; q < 4; ++q) { const int mq = (m + q * NGW < M) ? m + q * NGW : m; const f32x4* xr = (const f32x4*)(x + (size_t)mq * DM) + lane;
#pragma unroll
                for (int j = 0; j < 4; ++j) v[q][j] = __builtin_nontemporal_load(xr + 64 * j); }
#pragma unroll
            for (int q = 0; q < 4; ++q) { float a = 0.f;
#pragma unroll
                for (int j = 0; j < 4; ++j) a += (v[q][j][0] * v[q][j][0] + v[q][j][1] * v[q][j][1]) + (v[q][j][2] * v[q][j][2] + v[q][j][3] * v[q][j][3]);
                sq[q] = a; }
#pragma unroll
            for (int o = 1; o < 64; o <<= 1) {
#pragma unroll
                for (int q = 0; q < 4; ++q) sq[q] += __shfl_xor(sq[q], o); }
#pragma unroll
            for (int q = 0; q < 4; ++q) if (m + q * NGW < M) {
                const float r = 1.0f / sqrtf(sq[q] * (1.0f / DM) + EPS);
                u32x2* o8 = (u32x2*)(XN + (size_t)(m + q * NGW) * DM) + lane;
#pragma unroll
                for (int j = 0; j < 4; ++j) { u32x2 w; w.x = pk_bf16(v[q][j][0] * r * gn[j][0], v[q][j][1] * r * gn[j][1]); w.y = pk_bf16(v[q][j][2] * r * gn[j][2], v[q][j][3] * r * gn[j][3]); o8[64 * j] = w; }
            }
        }
    }
    grid.sync();
    (void)xcd_barrier_post(ctl + 20480, xst);

    {
        pg8::Gemm g{XN, WIN, M, NIN, DM}; pg8::StaticOrder S; S.init(M, NIN, G, (int)blockIdx.x, REP1, KDUP);
        EpiP1 E{YAB, VA, KB, VB, ZB, GA, GB, ssv, (LAS float*)(lds + LDS_MISC + 1024)};
        pg8::gemm_phase<EpiP1, pg8::StaticOrder>(lds, g, S, E);
    }
    xcd_barrier((unsigned*)((unsigned char*)args.ws + WS_CTL) + 20480, (volatile LAS unsigned*)(lds + LDS_MISC + 64));

    if (PHM & 4) {
        LAS int* uw = (LAS int*)(lds + LDS_MISC);
        if (tid == 0) uw[0] = (int)atomicAdd(ctl + 0, 1u);
        __syncthreads();
        int u = uw[0];
        for (int k = 0; u < N_ATT; ++k) {
            int unext = 0;
            if (tid == 0) unext = (int)atomicAdd(ctl + 0, 1u);
            {
                const int cls = 3 - (u >> 9), r = u & 511; const int qt = 7 - (r >> 6), j = r & 63; const int b = 4 * (j >> 3) + cls, h = j & 7;
                attn_unit(lds, b, h, qt, YAB, KB, VB, ZB, true); }
            if (tid == 0) uw[(k + 1) & 1] = unext;
            __syncthreads();
            u = uw[(k + 1) & 1];
        }
        __syncthreads();
        gmlp_phase(lds, (int)blockIdx.x, G, YAB, VA, ssv, w_s, b_s, norm_v);
    }
    xcd_barrier((unsigned*)((unsigned char*)args.ws + WS_CTL) + 20480, (volatile LAS unsigned*)(lds + LDS_MISC + 64));

    {
        pg8::Gemm g{YAB, WCAT, M, DM, 2048}; pg8::StaticOrder S; S.init(M, DM, G, (int)blockIdx.x, REP3);
        EpiP3 E{GA, GB, MG};
        pg8::gemm_phase<EpiP3, pg8::StaticOrder>(lds, g, S, E);
    }
    xcd_barrier((unsigned*)((unsigned char*)args.ws + WS_CTL) + 20480, (volatile LAS unsigned*)(lds + LDS_MISC + 64));

    {
        pg8::Gemm g{MG, WOUT, M, DM, DM}; pg8::StaticOrder S; S.init(M, DM, G, (int)blockIdx.x, REP4);
        EpiP4 E{x, out, norm_final, ssf, ctl + 1024};
        pg8::gemm_phase<EpiP4, pg8::StaticOrder>(lds, g, S, E);
    }
}

extern "C" void kernel_launch(void* const* d_in, const int* in_sizes, int n_in, void* d_out, int out_size, void* d_ws, size_t ws_size, hipStream_t stream) {
    static int grid_blocks = 0;
    if (grid_blocks == 0) {
        if (n_in != 10 || in_sizes[0] != M * DM || out_size != M * DM || ws_size < WS_END) { fprintf(stderr, "kernel_launch: unexpected shapes / workspace (%d inputs, ws %zu)\n", n_in, ws_size); grid_blocks = -1; return; }
        int dev = 0, cus = 0, per_cu = 0;
        hipGetDevice(&dev); hipDeviceGetAttribute(&cus, hipDeviceAttributeMultiprocessorCount, dev);
        hipFuncSetAttribute((const void*)fwd_megakernel, hipFuncAttributeMaxDynamicSharedMemorySize, LDS_BYTES);
        hipOccupancyMaxActiveBlocksPerMultiprocessor(&per_cu, (const void*)fwd_megakernel, 512, LDS_BYTES);
        if (per_cu < 1) per_cu = 1;
        grid_blocks = cus * per_cu;
        (void)hipGetLastError();
    }
    if (grid_blocks < 0) return;
    Args a{};
    for (int i = 0; i < 10; ++i) a.in[i] = (const float*)d_in[i];
    a.out = (float*)d_out; a.ws = (unsigned char*)d_ws;
    void* kargs[] = {&a};
    hipError_t e = hipLaunchCooperativeKernel((const void*)fwd_megakernel, dim3(grid_blocks), dim3(512), kargs, LDS_BYTES, stream);
    if (e != hipSuccess) fprintf(stderr, "cooperative launch failed: %s (grid %d)\n", hipGetErrorString(e), grid_blocks);
}
```
